# Optimizing an MI355X kernel written in HIP

```python
import jax, jax.numpy as jnp
from jax import lax
import numpy as np

D_MODEL = 1024
BATCH = 4
SEQ = 8192
DEPTH = 1
DEC_BATCH = 32
DEC_SEQ = 64
PAST_LEN = 1024

CHUNK = 64
D_POOL = D_MODEL // 2
POOL_WINDOWS = (2, 4, 8, 16)
N_POOL_GROUPS = 4
POOL_GROUP = D_POOL // N_POOL_GROUPS
POOL_STATE = 15
D_SGU = D_MODEL // 2
N_SGU_GROUPS = 4
SGU_GROUP = D_SGU // N_SGU_GROUPS
SGU_CHUNK = 128
D_IN = 2 * D_POOL + 3 * D_SGU + 2 * D_MODEL
EPS = 1e-6

kernel_name = "pool_sgu_gated_stream_encoder"


def _rmsnorm(x, g):
    xf = x.astype(jnp.float32)
    y = xf * lax.rsqrt(jnp.mean(xf * xf, axis=-1, keepdims=True) + EPS)
    return (y * g.astype(jnp.float32)).astype(x.dtype)


def _layernorm(x, g, b):
    xf = x.astype(jnp.float32)
    mu = jnp.mean(xf, axis=-1, keepdims=True)
    var = jnp.mean(jnp.square(xf - mu), axis=-1, keepdims=True)
    y = (xf - mu) * lax.rsqrt(var + EPS)
    return (y * g.astype(jnp.float32) + b.astype(jnp.float32)).astype(x.dtype)


def _pool_mix(a, prev, pos0):
    L = a.shape[1]
    ap = jnp.concatenate([prev.astype(a.dtype), a], axis=1).astype(jnp.float32)
    c = jnp.cumsum(ap, axis=1)
    c = jnp.concatenate([jnp.zeros_like(c[:, :1]), c], axis=1)
    pos = pos0 + jnp.arange(L)
    outs = []
    for g, w in enumerate(POOL_WINDOWS):
        lo, hi = g * POOL_GROUP, (g + 1) * POOL_GROUP
        s = POOL_STATE + 1
        win = c[:, s:s + L, lo:hi] - c[:, s - w:s - w + L, lo:hi]
        cnt = jnp.minimum(pos + 1, w).astype(jnp.float32)[None, :, None]
        outs.append(win / cnt)
    mean = jnp.concatenate(outs, axis=-1)
    return (mean - a.astype(jnp.float32)).astype(a.dtype)


def _spatial_gate(u, v, w_s, b_s, chunk_len):
    B, L, _ = v.shape
    n = L // chunk_len
    blk = jnp.arange(chunk_len) // CHUNK
    mask = blk[:, None] >= blk[None, :]
    w = jnp.where(mask[None], w_s[:, :chunk_len, :chunk_len], 0.0)
    vr = v.reshape(B, n, chunk_len, N_SGU_GROUPS, SGU_GROUP)
    z = jnp.einsum('gij,bnjgc->bnigc', w, vr)
    z = z + b_s[:, :chunk_len].T[None, None, :, :, None]
    return u * z.reshape(B, L, D_SGU)


def _layer(x, prev_pool, pos0, sgu_chunk, norm_g, w_in, w_pool, pool_scale, ln_g, ln_b, w_s, b_s, w_a, w_b, w_o):
    B, L, _ = x.shape
    h = _rmsnorm(x, norm_g)
    proj = h @ w_in
    sizes = (D_POOL, D_POOL, D_SGU, D_SGU, D_SGU, D_MODEL, D_MODEL)
    idx = np.cumsum(sizes)[:-1].tolist()
    a, g_a, u, v, g_b, r_a, r_b = jnp.split(proj, idx, axis=-1)
    pa = _pool_mix(a, prev_pool, pos0).reshape(B, L, N_POOL_GROUPS, POOL_GROUP)
    pa = jnp.einsum('blgc,gcd->blgd', pa, w_pool).reshape(B, L, D_POOL) * pool_scale
    y_a = (jax.nn.silu(g_a) * pa) @ w_a
    v_hat = _layernorm(v, ln_g, ln_b)
    y_b = (jax.nn.silu(g_b) * _spatial_gate(u, v_hat, w_s, b_s, sgu_chunk)) @ w_b
    merged = jax.nn.sigmoid(r_a) * y_a + jax.nn.sigmoid(r_b) * y_b
    return x + merged @ w_o, a, v_hat


def setup_inputs(seed: int = 0) -> dict:
    key = jax.random.key(seed)
    ks = jax.random.split(key, 16)
    f32 = jnp.float32

    def nrm(k, shape, scale):
        return scale * jax.random.normal(k, shape, f32)

    return {
        "x_prompt": nrm(ks[0], (BATCH, SEQ, D_MODEL), 1.0),
        "x_sample": nrm(ks[1], (DEC_BATCH, DEC_SEQ, D_MODEL), 1.0),
        "cache_pool": nrm(ks[2], (DEPTH, DEC_BATCH, POOL_STATE, D_POOL), 1.0),
        "norm_g": 1.0 + nrm(ks[3], (DEPTH, D_MODEL), 0.05),
        "w_in": nrm(ks[4], (DEPTH, D_MODEL, D_IN), D_MODEL ** -0.5),
        "w_pool": nrm(ks[5], (DEPTH, N_POOL_GROUPS, POOL_GROUP, POOL_GROUP), POOL_GROUP ** -0.5),
        "pool_scale": 1.0 + nrm(ks[6], (DEPTH, D_POOL), 0.1),
        "ln_g": 1.0 + nrm(ks[7], (DEPTH, D_SGU), 0.05),
        "ln_b": nrm(ks[8], (DEPTH, D_SGU), 0.02),
        "w_s": nrm(ks[9], (DEPTH, N_SGU_GROUPS, SGU_CHUNK, SGU_CHUNK), SGU_CHUNK ** -0.5),
        "b_s": 1.0 + nrm(ks[10], (DEPTH, N_SGU_GROUPS, SGU_CHUNK), 0.1),
        "w_a": nrm(ks[11], (DEPTH, D_POOL, D_MODEL), D_POOL ** -0.5),
        "w_b": nrm(ks[12], (DEPTH, D_SGU, D_MODEL), D_SGU ** -0.5),
        "w_o": nrm(ks[13], (DEPTH, D_MODEL, D_MODEL), D_MODEL ** -0.5),
        "final_g": 1.0 + nrm(ks[14], (D_MODEL,), 0.05),
    }


def reference(x_prompt, x_sample, cache_pool, norm_g, w_in, w_pool, pool_scale, ln_g, ln_b, w_s, b_s,
              w_a, w_b, w_o, final_g):
    xp, xs = x_prompt, x_sample
    pool_p, pool_s, v_s = [], [], []
    for l in range(DEPTH):
        params = (norm_g[l], w_in[l], w_pool[l], pool_scale[l], ln_g[l], ln_b[l], w_s[l], b_s[l],
                  w_a[l], w_b[l], w_o[l])
        no_hist = jnp.zeros((xp.shape[0], POOL_STATE, D_POOL), xp.dtype)
        xp, a_p, _ = _layer(xp, no_hist, 0, SGU_CHUNK, *params)
        xs, a_s, vh_s = _layer(xs, cache_pool[l], PAST_LEN, xs.shape[1], *params)
        pool_p.append(a_p[:, -POOL_STATE:])
        pool_s.append(jnp.concatenate([cache_pool[l].astype(a_s.dtype), a_s], axis=1)[:, -POOL_STATE:])
        v_s.append(vh_s)
    y_prompt = _rmsnorm(xp, final_g)
    y_sample = _rmsnorm(xs, final_g)
    state_pool_prompt = jnp.stack(pool_p)
    state_pool_sample = jnp.stack(pool_s)
    state_v_sample = jnp.stack(v_s)
    return (y_prompt, y_sample, state_pool_prompt, state_pool_sample, state_v_sample)
```

```cpp
#include <hip/hip_runtime.h>
#include <hip/hip_cooperative_groups.h>
#include <cstdio>
#include <cstdint>
namespace cg = cooperative_groups;

#define LAS __attribute__((address_space(3)))
typedef unsigned short bf16_t;
typedef short bf16x8 __attribute__((ext_vector_type(8)));
typedef float f32x4 __attribute__((ext_vector_type(4)));
typedef unsigned u32x4 __attribute__((ext_vector_type(4)));

constexpr int DM = 1024, NP = 4 * 8192, NS = 32 * 64, MTOK = NP + NS, DIN = 4608, SEQ = 8192;
constexpr int C_A = 0, C_GA = 512, C_U = 1024, C_V = 1536, C_GB = 2048, C_RA = 2560, C_RB = 3584;
constexpr float EPS = 1e-6f;
constexpr size_t OUT_YS = (size_t)NP * DM, OUT_SPP = (size_t)MTOK * DM, OUT_SPS = OUT_SPP + 4 * 15 * 512, OUT_SV = OUT_SPS + 32 * 15 * 512;
constexpr size_t MiB = 1u << 20;
constexpr size_t WS_VSTAT = 0, WS_SS = 512 * 1024, WS_WIN = 1 * MiB, WS_WAB = 10 * MiB, WS_WO = 12 * MiB, WS_WPOOL = 14 * MiB, WS_WSB = 14 * MiB + 131072;
constexpr size_t WS_H = 16 * MiB, WS_T = 84 * MiB, WS_PROJ = 152 * MiB;
constexpr int NWAVES = 8, NTHREADS = 512;
constexpr int LDS_BYTES = 155648;

__device__ __forceinline__ unsigned cvt_pk_bf16(float lo, float hi) { unsigned r; asm volatile("v_cvt_pk_bf16_f32 %0, %1, %2" : "=v"(r) : "v"(lo), "v"(hi)); return r; }
__device__ __forceinline__ float bf_lo(unsigned w) { return __uint_as_float(w << 16); }
__device__ __forceinline__ float bf_hi(unsigned w) { return __uint_as_float(w & 0xffff0000u); }
__device__ __forceinline__ float sigmoidf_fast(float x) { return __builtin_amdgcn_rcpf(1.f + __builtin_amdgcn_exp2f(-1.44269504f * x)); }
__device__ __forceinline__ u32x4 pack8(const f32x4 a, const f32x4 b) { u32x4 w; w.x = cvt_pk_bf16(a[0], a[1]); w.y = cvt_pk_bf16(a[2], a[3]); w.z = cvt_pk_bf16(b[0], b[1]); w.w = cvt_pk_bf16(b[2], b[3]); return w; }
__device__ __forceinline__ void unpack8(const u32x4 w, f32x4& a, f32x4& b) { a = (f32x4){bf_lo(w.x), bf_hi(w.x), bf_lo(w.y), bf_hi(w.y)}; b = (f32x4){bf_lo(w.z), bf_hi(w.z), bf_lo(w.w), bf_hi(w.w)}; }

namespace pg8 {
constexpr int BM = 256, BK = 64, HALF = 128, HTB = HALF * BK * 2, STAGE_BYTES = 8 * HTB, NXCD = 8, WGM = 8;
__host__ __device__ __forceinline__ int lds_byte(int r, int c) { const int st = (r >> 4) * 2 + (c >> 5), rr = r & 15, cc = c & 31, ob = rr * 64 + cc * 2; return st * 1024 + (ob ^ (((ob >> 9) & 1) << 5)); }
__host__ __device__ __forceinline__ void stage_rc(int b, int& R, int& C) { const int st = b / 1024, sb = b % 1024, swz = sb ^ (((sb >> 9) & 1) << 5); R = (st >> 1) * 16 + swz / 64; C = (st & 1) * 32 + (swz % 64) / 2; }
__host__ __device__ __forceinline__ int perm32(int rho) { const int n = rho >> 4, i = rho & 15; return 8 * (i >> 2) + 4 * n + (i & 3); }

struct Unit { int pm, pn, kh; };
struct Gemm { const bf16_t* A; const bf16_t* Bt; int lda, ldb, nt, khA, khB; };

struct Order {
    int nM, nN, nwg, G, c, nkh;
    __device__ void init(int M, int N, int G_, int c_, int nkh_) { nM = M / BM; nN = N / BM; nwg = nM * nN; G = G_; c = c_; nkh = nkh_; }
    __device__ bool next(int i, Unit& u) const {
        const int ti = (nkh == 2) ? (i >> 1) : i; u.kh = (nkh == 2) ? (i & 1) : 0;
        const long L = (long)ti * G + c; if (L >= nwg) return false;
        int wgid = (int)L; { const int q = nwg / NXCD, r = nwg % NXCD, xcd = wgid % NXCD, off = wgid / NXCD; wgid = (xcd < r ? xcd * (q + 1) : r * (q + 1) + (xcd - r) * q) + off; }
        const int nig = WGM * nN, gid = wgid / nig, fm = gid * WGM, gsz = (nM - fm) < WGM ? (nM - fm) : WGM;
        u.pm = fm + ((wgid % nig) % gsz); u.pn = (wgid % nig) / gsz; return true;
    }
};

template <class Epi, class Sched>
__device__ __forceinline__ void gemm_phase(LAS unsigned char* lds, const Gemm g, const Sched& S, const Epi& E) {
    const int tid = threadIdx.x, wid = __builtin_amdgcn_readfirstlane(tid >> 6), lane = tid & 63, wr = wid >> 2, wc = wid & 3, fr = lane & 15, fq = lane >> 4;
    const int nt = g.nt;
    unsigned voffA[2], voffB[2];
#pragma unroll
    for (int i = 0; i < 2; ++i) { int R, C; stage_rc(tid * 16 + i * 8192, R, C); const int Rb = (R & ~31) + perm32(R & 31);
        voffA[i] = (unsigned)(R * g.lda + C) * 2u; voffB[i] = (unsigned)(Rb * g.ldb + C) * 2u; }
    const size_t kstep = (size_t)(BK * 2);
    const size_t hstepA = (size_t)HALF * g.lda * 2, hstepB = (size_t)HALF * g.ldb * 2;
    const size_t tstepA = 2 * hstepA, tstepB = 2 * hstepB;
    const unsigned ldsw = (unsigned)wid * 1024u;
    const int aoff = lds_byte(wr * 64 + fr, fq * 8), boff = lds_byte(wc * 32 + fr, fq * 8);
#define PG8_SA(b, h) (((b) * 2 + (h)) * HTB)
#define PG8_SB(b, h) ((4 + (b) * 2 + (h)) * HTB)
#define PG8_STAGE(bufoff, gbase, voff) do { _Pragma("unroll") for (int _i = 0; _i < 2; ++_i) \
        __builtin_amdgcn_global_load_lds((const unsigned*)((const char*)(gbase) + (voff)[_i]), (LAS unsigned*)(lds + (bufoff) + ldsw + _i * 8192), 16, 0, 0); } while (0)
#define PG8_LDA(dst, b, h) do { _Pragma("unroll") for (int m = 0; m < 4; ++m) _Pragma("unroll") for (int k = 0; k < 2; ++k) dst[m][k] = *(const LAS bf16x8*)(lds + PG8_SA(b, h) + aoff + m * 2048 + k * 1024); } while (0)
#define PG8_LDB(dst, b, h) do { _Pragma("unroll") for (int n = 0; n < 2; ++n) _Pragma("unroll") for (int k = 0; k < 2; ++k) dst[n][k] = *(const LAS bf16x8*)(lds + PG8_SB(b, h) + boff + n * 2048 + k * 1024); } while (0)
#define PG8_MMA(ai, bj, At, Bt) do { __builtin_amdgcn_s_setprio(1); _Pragma("unroll") for (int m = 0; m < 4; ++m) _Pragma("unroll") for (int n = 0; n < 2; ++n) _Pragma("unroll") for (int k = 0; k < 2; ++k) \
        acc[ai][bj][m][n] = __builtin_amdgcn_mfma_f32_16x16x32_bf16(Bt[n][k], At[m][k], acc[ai][bj][m][n], 0, 0, 0); __builtin_amdgcn_s_setprio(0); } while (0)
#define PG8_WAIT_V(n) asm volatile("s_waitcnt vmcnt(" #n ")" ::: "memory")
#define PG8_WAIT_L(n) asm volatile("s_waitcnt lgkmcnt(" #n ")" ::: "memory")
#define PG8_BAR __builtin_amdgcn_s_barrier()
#define PG8_SCHED __builtin_amdgcn_sched_barrier(0)
#define PG8_ZERO() do { _Pragma("unroll") for (int a = 0; a < 2; ++a) _Pragma("unroll") for (int b = 0; b < 2; ++b) _Pragma("unroll") for (int m = 0; m < 4; ++m) _Pragma("unroll") for (int n = 0; n < 2; ++n) acc[a][b][m][n] = (f32x4){0.f, 0.f, 0.f, 0.f}; } while (0)
    Unit cur, nxt; int ui = 0;
    if (!S.next(0, cur)) return;
    f32x4 acc[2][2][4][2];
    PG8_ZERO();
    bf16x8 At[4][2], B0[2][2], B1[2][2];
    const char* cA = (const char*)g.A + (size_t)cur.pm * tstepA + (size_t)cur.kh * g.khA; const char* cB = (const char*)g.Bt + (size_t)cur.pn * tstepB + (size_t)cur.kh * g.khB;
    PG8_STAGE(PG8_SB(0, 0), cB, voffB); PG8_STAGE(PG8_SB(0, 1), cB + hstepB, voffB); PG8_STAGE(PG8_SA(0, 0), cA, voffA); PG8_STAGE(PG8_SA(0, 1), cA + hstepA, voffA);
    if (wr == 1) PG8_BAR;
    PG8_WAIT_V(2); PG8_BAR;
    PG8_STAGE(PG8_SB(1, 0), cB + kstep, voffB); PG8_STAGE(PG8_SA(1, 0), cA + kstep, voffA); PG8_STAGE(PG8_SB(1, 1), cB + hstepB + kstep, voffB);
    PG8_WAIT_V(6); PG8_BAR;
    for (;;) {
        const bool has_next = S.next(ui + 1, nxt);
        const char* nA = has_next ? (const char*)g.A + (size_t)nxt.pm * tstepA + (size_t)nxt.kh * g.khA : cA; const char* nB = has_next ? (const char*)g.Bt + (size_t)nxt.pn * tstepB + (size_t)nxt.kh * g.khB : cB;
        for (int t = 0; t < nt; t += 2) {
            const bool last = (t == nt - 2);
            const char* a1 = cA + (size_t)(t + 1) * kstep;
            const char* a2 = last ? nA : cA + (size_t)(t + 2) * kstep; const char* b2 = last ? nB : cB + (size_t)(t + 2) * kstep;
            const char* a3 = a2 + kstep; const char* b3 = b2 + kstep;
            PG8_LDB(B0, 0, 0); PG8_LDB(B1, 0, 1); PG8_SCHED; PG8_LDA(At, 0, 0); PG8_STAGE(PG8_SA(1, 1), a1 + hstepA, voffA);
            PG8_WAIT_V(8); PG8_WAIT_L(0); PG8_BAR; PG8_MMA(0, 0, At, B0); PG8_MMA(0, 1, At, B1); PG8_BAR; PG8_SCHED;
            PG8_LDA(At, 0, 1); PG8_STAGE(PG8_SB(0, 0), b2, voffB); PG8_STAGE(PG8_SB(0, 1), b2 + hstepB, voffB); PG8_STAGE(PG8_SA(0, 0), a2, voffA);
            PG8_WAIT_V(8); PG8_WAIT_L(0); PG8_BAR; PG8_MMA(1, 0, At, B0); PG8_MMA(1, 1, At, B1); PG8_BAR; PG8_SCHED;
            PG8_LDB(B0, 1, 0); PG8_LDB(B1, 1, 1); PG8_SCHED; PG8_LDA(At, 1, 0); PG8_STAGE(PG8_SA(0, 1), a2 + hstepA, voffA);
            PG8_WAIT_V(8); PG8_WAIT_L(0); PG8_BAR; PG8_MMA(0, 0, At, B0); PG8_MMA(0, 1, At, B1); PG8_BAR; PG8_SCHED;
            PG8_LDA(At, 1, 1); PG8_STAGE(PG8_SB(1, 0), b3, voffB); PG8_STAGE(PG8_SB(1, 1), b3 + hstepB, voffB); PG8_STAGE(PG8_SA(1, 0), a3, voffA);
            PG8_WAIT_V(8); PG8_WAIT_L(0); PG8_BAR; PG8_MMA(1, 0, At, B0); PG8_MMA(1, 1, At, B1); PG8_BAR; PG8_SCHED;
        }
        if (wr == 0) PG8_BAR;
        E(acc, cur, wr, wc, fr, fq);
        if (!has_next) break;
        if (!Epi::keep(cur)) PG8_ZERO();
        cur = nxt; cA = nA; cB = nB; ++ui;
        if (wr == 1) PG8_BAR;
    }
    PG8_WAIT_V(0);
    PG8_BAR;
#undef PG8_SA
#undef PG8_SB
#undef PG8_STAGE
#undef PG8_LDA
#undef PG8_LDB
#undef PG8_MMA
#undef PG8_WAIT_V
#undef PG8_WAIT_L
#undef PG8_BAR
#undef PG8_SCHED
#undef PG8_ZERO
}
}
using pg8::Unit;

struct EpiProj {
    bf16_t* proj; float* vstat;
    static __device__ __forceinline__ bool keep(const Unit&) { return false; }
    __device__ __forceinline__ void operator()(f32x4 (&acc)[2][2][4][2], const Unit& u, int wr, int wc, int fr, int fq) const {
        const int row0 = u.pm * 256 + wr * 64 + fr, col0 = u.pn * 256 + wc * 32 + 8 * fq;
        const int pn = u.pn;
        const int kind = (pn >= 10) ? 2 : ((pn == 2 || pn == 3 || pn == 8 || pn == 9) ? 1 : ((pn == 6 || pn == 7) ? 3 : 0));
#pragma unroll
        for (int ai = 0; ai < 2; ++ai)
#pragma unroll
            for (int m = 0; m < 4; ++m) {
                const int row = row0 + ai * 128 + m * 16;
                bf16_t* rowp = proj + (size_t)row * DIN + col0;
                float s1 = 0.f, s2 = 0.f;
#pragma unroll
                for (int bj = 0; bj < 2; ++bj) {
                    f32x4 v0 = acc[ai][bj][m][0], v1 = acc[ai][bj][m][1];
                    if (kind == 1) {
#pragma unroll
                        for (int e = 0; e < 4; ++e) { v0[e] = v0[e] * sigmoidf_fast(v0[e]); v1[e] = v1[e] * sigmoidf_fast(v1[e]); }
                    } else if (kind == 2) {
#pragma unroll
                        for (int e = 0; e < 4; ++e) { v0[e] = sigmoidf_fast(v0[e]); v1[e] = sigmoidf_fast(v1[e]); }
                    } else if (kind == 3) {
#pragma unroll
                        for (int e = 0; e < 4; ++e) { s1 += v0[e] + v1[e]; s2 += v0[e] * v0[e] + v1[e] * v1[e]; }
                    }
                    *(u32x4*)(rowp + bj * 128) = pack8(v0, v1);
                }
                if (kind == 3) {
                    s1 += __shfl_xor(s1, 16); s1 += __shfl_xor(s1, 32); s2 += __shfl_xor(s2, 16); s2 += __shfl_xor(s2, 32);
                    if (fq == 0) { atomicAdd(vstat + 2 * row, s1); atomicAdd(vstat + 2 * row + 1, s2); }
                }
            }
    }
};
struct EpiMerge {
    const bf16_t* proj; bf16_t* outm;
    static __device__ __forceinline__ bool keep(const Unit& u) { return u.kh == 0; }
    __device__ __forceinline__ void operator()(f32x4 (&acc)[2][2][4][2], const Unit& u, int wr, int wc, int fr, int fq) const {
        const int row0 = u.pm * 256 + wr * 64 + fr, col0 = u.pn * 256 + wc * 32 + 8 * fq;
#pragma unroll
        for (int ai = 0; ai < 2; ++ai)
#pragma unroll
            for (int m = 0; m < 4; ++m) {
                const int row = row0 + ai * 128 + m * 16;
                const bf16_t* pr = proj + (size_t)row * DIN;
#pragma unroll
                for (int bj = 0; bj < 2; ++bj) {
                    const int c = col0 + bj * 128;
                    f32x4 b0, b1; unpack8(*(const u32x4*)(pr + C_RB + c), b0, b1);
                    if (u.kh == 0) {
                        f32x4 a0, a1; unpack8(*(const u32x4*)(pr + C_RA + c), a0, a1);
#pragma unroll
                        for (int e = 0; e < 4; ++e) { acc[ai][bj][m][0][e] *= a0[e] * __builtin_amdgcn_rcpf(b0[e]); acc[ai][bj][m][1][e] *= a1[e] * __builtin_amdgcn_rcpf(b1[e]); }
                    } else {
                        const f32x4 v0 = acc[ai][bj][m][0] * b0, v1 = acc[ai][bj][m][1] * b1;
                        *(u32x4*)(outm + (size_t)row * DM + c) = pack8(v0, v1);
                    }
                }
            }
    }
};
struct EpiOut {
    const float* xp; const float* xs; float* out; float* ss;
    static __device__ __forceinline__ bool keep(const Unit&) { return false; }
    __device__ __forceinline__ void operator()(f32x4 (&acc)[2][2][4][2], const Unit& u, int wr, int wc, int fr, int fq) const {
        const int row0 = u.pm * 256 + wr * 64 + fr, col0 = u.pn * 256 + wc * 32 + 8 * fq;
#pragma unroll
        for (int ai = 0; ai < 2; ++ai)
#pragma unroll
            for (int m = 0; m < 4; ++m) {
                const int row = row0 + ai * 128 + m * 16;
                const float* xr = (row < NP) ? xp + (size_t)row * DM : xs + (size_t)(row - NP) * DM;
                float* orow = out + (size_t)row * DM;
                float q = 0.f;
#pragma unroll
                for (int bj = 0; bj < 2; ++bj) {
                    const int c = col0 + bj * 128;
                    const f32x4 o0 = *(const f32x4*)(xr + c) + acc[ai][bj][m][0], o1 = *(const f32x4*)(xr + c + 4) + acc[ai][bj][m][1];
                    *(f32x4*)(orow + c) = o0; *(f32x4*)(orow + c + 4) = o1;
                    q += (o0[0] * o0[0] + o0[1] * o0[1]) + (o0[2] * o0[2] + o0[3] * o0[3]) + (o1[0] * o1[0] + o1[1] * o1[1]) + (o1[2] * o1[2] + o1[3] * o1[3]);
                }
                q += __shfl_xor(q, 16); q += __shfl_xor(q, 32);
                if (fq == 0) atomicAdd(ss + row, q);
            }
    }
};

struct Params {
    const float *xp, *xs, *cache, *norm_g, *w_in, *w_pool, *pool_scale, *ln_g, *ln_b, *w_s, *b_s, *w_a, *w_b, *w_o, *final_g;
    float* out; unsigned char* ws;
};
struct Frame {
    LAS unsigned char* lds; int tid, lane, wave, vcu, G;
    bf16_t *Win_t, *Wab_t, *Wo_t, *Wpool_t, *Ws_b, *H, *T, *PROJ;
    float *vstat, *ss;
};
#define LDS_WAIT() asm volatile("s_waitcnt lgkmcnt(0)" ::: "memory")
__device__ __forceinline__ float wave_sum(float v) {
#pragma unroll
    for (int o = 1; o < 64; o <<= 1) v += __shfl_xor(v, o);
    return v;
}
__device__ __forceinline__ void transpose_item(const float* W, int N, bf16_t* WT, int ldt, LAS float* scr, int item, int nblk, int lane) {
    const int kb = item / nblk, nb = item % nblk, k0 = 64 * kb, n0 = 32 * nb;
#pragma unroll 8
    for (int i = 0; i < 32; ++i) { const int kk = 2 * i + (lane >> 5); scr[kk * 33 + (lane & 31)] = W[(size_t)(k0 + kk) * N + n0 + (lane & 31)]; }
    LDS_WAIT(); asm volatile("" ::: "memory");
    const int c = lane & 7;
#pragma unroll
    for (int j = 0; j < 4; ++j) { const int n = (lane >> 3) + 8 * j; const LAS float* s = scr + (8 * c) * 33 + n;
        u32x4 o; o.x = cvt_pk_bf16(s[0 * 33], s[1 * 33]); o.y = cvt_pk_bf16(s[2 * 33], s[3 * 33]); o.z = cvt_pk_bf16(s[4 * 33], s[5 * 33]); o.w = cvt_pk_bf16(s[6 * 33], s[7 * 33]);
        *(u32x4*)(WT + (size_t)(n0 + n) * ldt + k0 + 8 * c) = o; }
    LDS_WAIT(); asm volatile("" ::: "memory");
}

__device__ __forceinline__ void p0_prologue(const Params& P, Frame& F) {
    LAS float* scr = (LAS float*)(F.lds + F.wave * 16384);
    const int gw = F.vcu * NWAVES + F.wave, NGW = F.G * NWAVES, lane = F.lane;
    constexpr int I_IN = 16 * 144, I_A = 8 * 32, I_O = 16 * 32, I_P = 2 * 4;
    constexpr int NITEMS = I_IN + 2 * I_A + I_O + 4 * I_P;
    for (int it = gw; it < NITEMS; it += NGW) {
        int r = it;
        if (r < I_IN) { transpose_item(P.w_in, DIN, F.Win_t, 1024, scr, r, 144, lane); continue; } r -= I_IN;
        if (r < I_A) { transpose_item(P.w_a, 1024, F.Wab_t, 1024, scr, r, 32, lane); continue; } r -= I_A;
        if (r < I_A) { transpose_item(P.w_b, 1024, F.Wab_t + 512, 1024, scr, r, 32, lane); continue; } r -= I_A;
        if (r < I_O) { transpose_item(P.w_o, 1024, F.Wo_t, 1024, scr, r, 32, lane); continue; } r -= I_O;
        { const int g = r / I_P; transpose_item(P.w_pool + g * 16384, 128, F.Wpool_t + g * 16384, 128, scr, r % I_P, 4, lane); }
    }
    const int gt = F.vcu * NTHREADS + F.tid, NGT = F.G * NTHREADS;
    for (int e = gt; e < 4 * 128 * 128 / 2; e += NGT) { const int i = (e >> 6) & 127, j = (e & 63) * 2; const float lo = P.w_s[2 * e], hi = P.w_s[2 * e + 1]; const bool z = (i < 64 && j >= 64);
        ((unsigned*)F.Ws_b)[e] = z ? 0u : cvt_pk_bf16(lo, hi); }
    for (int e = gt; e < MTOK * 2; e += NGT) F.vstat[e] = 0.f;
    for (int e = gt; e < MTOK; e += NGT) F.ss[e] = 0.f;
    f32x4 gv[4];
#pragma unroll
    for (int j = 0; j < 4; ++j) gv[j] = *((const f32x4*)P.norm_g + lane + 64 * j);
    for (int m = gw; m < MTOK; m += NGW) {
        const float* xrow = (m < NP) ? P.xp + (size_t)m * DM : P.xs + (size_t)(m - NP) * DM;
        const f32x4* xr = (const f32x4*)xrow + lane;
        f32x4 v[4]; float s = 0.f;
#pragma unroll
        for (int j = 0; j < 4; ++j) { v[j] = xr[64 * j]; s += (v[j].x * v[j].x + v[j].y * v[j].y) + (v[j].z * v[j].z + v[j].w * v[j].w); }
        const float r = 1.f / sqrtf(wave_sum(s) * (1.f / DM) + EPS);
        unsigned long long* o8 = (unsigned long long*)(F.H + (size_t)m * DM) + lane;
#pragma unroll
        for (int j = 0; j < 4; ++j) { const f32x4 h = v[j] * r * gv[j]; o8[64 * j] = (unsigned long long)cvt_pk_bf16(h.x, h.y) | ((unsigned long long)cvt_pk_bf16(h.z, h.w) << 32); }
    }
}

__device__ __forceinline__ void pool_unit(const Params& P, Frame& F, int rt, int g) {
    const int tid = F.tid, lane = F.lane, fr = lane & 15, fq = lane >> 4, wd = F.wave & 3, wt = F.wave >> 2;
    const int R0 = rt * 128; const bool smp = R0 >= NP;
    LAS float* aT = (LAS float*)F.lds;
    LAS bf16_t* PA = (LAS bf16_t*)(F.lds + 81920);
    bf16x8 wA[2][4];
    { const bf16_t* wp = F.Wpool_t + g * 16384;
#pragma unroll
      for (int n = 0; n < 2; ++n) { const int d = 32 * wd + 8 * (fr >> 2) + 4 * n + (fr & 3);
#pragma unroll
        for (int kk = 0; kk < 4; ++kk) wA[n][kk] = *(const bf16x8*)(wp + d * 128 + kk * 32 + fq * 8); } }
#pragma unroll
    for (int q = 0; q < 5; ++q) {
        const int p = tid + 512 * q, seg = p / 1280, rem = p - seg * 1280, r = rem >> 4, cb = rem & 15, rel = r - 16;
        const int segrow = R0 + 64 * seg;
        f32x4 lo = (f32x4){0.f, 0.f, 0.f, 0.f}, hi = lo;
        if (rel >= 0 || (!smp && (segrow & (SEQ - 1)) != 0)) {
            unpack8(*(const u32x4*)(F.PROJ + (size_t)(segrow + rel) * DIN + C_A + g * 128 + cb * 8), lo, hi);
        } else if (smp && rel >= -15) {
            const int s = (segrow - NP) >> 6; const float* cp = P.cache + ((size_t)s * 15 + (15 + rel)) * 512 + g * 128 + cb * 8;
            lo = *(const f32x4*)cp; hi = *(const f32x4*)(cp + 4);
        }
        LAS float* dst = aT + (seg * 80 + r) * 128 + cb * 8;
        *(LAS f32x4*)dst = lo; *(LAS f32x4*)(dst + 4) = hi;
    }
    __syncthreads();
    {
        const int c = tid & 127, q = tid >> 7, seg = q >> 1, k0 = 32 * (q & 1), w = 2 << g;
        const int segrow = R0 + 64 * seg, tpos0 = segrow & (SEQ - 1);
        const LAS float* base = aT + (seg * 80 + 16) * 128 + c;
        float S = 0.f;
        for (int d = 1; d < w; ++d) S += base[(k0 - d) * 128];
        const float invw = 1.f / (float)w;
        for (int k = k0; k < k0 + 32; ++k) {
            const float a = base[k * 128]; S += a;
            float inv = invw;
            if (!smp) { const int t = tpos0 + k; if (t + 1 < w) inv = 1.f / (float)(t + 1); }
            const float o = S * inv - a;
            PA[(64 * seg + k) * 136 + c] = (bf16_t)(cvt_pk_bf16(o, 0.f) & 0xffffu);
            S -= base[(k - w + 1) * 128];
            if (!smp) { const int t = tpos0 + k; if (t >= SEQ - 15) P.out[OUT_SPP + ((size_t)(R0 >> 13) * 15 + (t - (SEQ - 15))) * 512 + g * 128 + c] = a; }
            else if (k >= 49) { const int s = (segrow - NP) >> 6; P.out[OUT_SPS + ((size_t)s * 15 + (k - 49)) * 512 + g * 128 + c] = a; }
        }
    }
    __syncthreads();
    f32x4 acc[4][2];
#pragma unroll
    for (int nb = 0; nb < 4; ++nb) { acc[nb][0] = (f32x4){0.f, 0.f, 0.f, 0.f}; acc[nb][1] = acc[nb][0]; }
#pragma unroll
    for (int nb = 0; nb < 4; ++nb) {
        const LAS bf16_t* pr = PA + (64 * wt + 16 * nb + fr) * 136 + fq * 8;
#pragma unroll
        for (int kk = 0; kk < 4; ++kk) {
            const bf16x8 b = *(const LAS bf16x8*)(pr + kk * 32);
            acc[nb][0] = __builtin_amdgcn_mfma_f32_16x16x32_bf16(wA[0][kk], b, acc[nb][0], 0, 0, 0);
            acc[nb][1] = __builtin_amdgcn_mfma_f32_16x16x32_bf16(wA[1][kk], b, acc[nb][1], 0, 0, 0);
        }
    }
    const int d0 = g * 128 + 32 * wd + 8 * fq;
    const f32x4 ps0 = *(const f32x4*)(P.pool_scale + d0), ps1 = *(const f32x4*)(P.pool_scale + d0 + 4);
#pragma unroll
    for (int nb = 0; nb < 4; ++nb) {
        const int row = R0 + 64 * wt + 16 * nb + fr;
        f32x4 s0, s1; unpack8(*(const u32x4*)(F.PROJ + (size_t)row * DIN + C_GA + d0), s0, s1);
        *(u32x4*)(F.T + (size_t)row * DM + d0) = pack8(acc[nb][0] * ps0 * s0, acc[nb][1] * ps1 * s1);
    }
    __syncthreads();
}
__device__ __forceinline__ void sgu_unit(const Params& P, Frame& F, int rt, int g) {
    const int tid = F.tid, lane = F.lane, fr = lane & 15, fq = lane >> 4, wcg = F.wave & 3, wt = F.wave >> 2;
    const int R0 = rt * 128; const bool smp = R0 >= NP;
    LAS bf16_t* VH = (LAS bf16_t*)(F.lds + 116736);
    const bool k_lo = (wt == 0) || !smp, k_hi = (wt == 1);
    bf16x8 wB[4][4];
    { const bf16_t* wp = F.Ws_b + g * 16384;
#pragma unroll
      for (int nb = 0; nb < 4; ++nb) { const int i = 64 * wt + 16 * nb + fr;
#pragma unroll
        for (int kk = 0; kk < 4; ++kk) {
            const bool need = (kk < 2) ? k_lo : k_hi;
            const bf16_t* src = (smp && wt == 1) ? wp + (i - 64) * 128 + (kk * 32 - 64) + fq * 8 : wp + i * 128 + kk * 32 + fq * 8;
            if (need) wB[nb][kk] = *(const bf16x8*)src; else wB[nb][kk] = (bf16x8){0, 0, 0, 0, 0, 0, 0, 0};
        } } }
    {
        const int cb = tid & 15;
        const f32x4 lg0 = *(const f32x4*)(P.ln_g + g * 128 + cb * 8), lg1 = *(const f32x4*)(P.ln_g + g * 128 + cb * 8 + 4);
        const f32x4 lb0 = *(const f32x4*)(P.ln_b + g * 128 + cb * 8), lb1 = *(const f32x4*)(P.ln_b + g * 128 + cb * 8 + 4);
#pragma unroll
        for (int q = 0; q < 4; ++q) {
            const int j = (tid >> 4) + 32 * q, row = R0 + j;
            f32x4 v0, v1; unpack8(*(const u32x4*)(F.PROJ + (size_t)row * DIN + C_V + g * 128 + cb * 8), v0, v1);
            const float s1 = F.vstat[2 * row], s2 = F.vstat[2 * row + 1];
            const float mean = s1 * (1.f / 512.f), var = fmaxf(s2 * (1.f / 512.f) - mean * mean, 0.f), rstd = 1.f / sqrtf(var + EPS);
            v0 = (v0 - mean) * rstd * lg0 + lb0; v1 = (v1 - mean) * rstd * lg1 + lb1;
            if (smp) { float* o = P.out + OUT_SV + (size_t)(row - NP) * 512 + g * 128 + cb * 8; *(f32x4*)o = v0; *(f32x4*)(o + 4) = v1; }
            *(LAS u32x4*)(VH + j * 136 + cb * 8) = pack8(v0, v1);
        }
    }
    __syncthreads();
    f32x4 acc[4][2];
#pragma unroll
    for (int nb = 0; nb < 4; ++nb) { acc[nb][0] = (f32x4){0.f, 0.f, 0.f, 0.f}; acc[nb][1] = acc[nb][0]; }
#pragma unroll
    for (int kk = 0; kk < 4; ++kk) {
        const bool need = (kk < 2) ? k_lo : k_hi;
        if (need) {
            bf16x8 a[2];
#pragma unroll
            for (int n = 0; n < 2; ++n) { const int c = 32 * wcg + 8 * (fr >> 2) + 4 * n + (fr & 3); const LAS bf16_t* vp = VH + (kk * 32 + fq * 8) * 136 + c;
#pragma unroll
                for (int e = 0; e < 8; ++e) a[n][e] = (short)vp[e * 136]; }
#pragma unroll
            for (int nb = 0; nb < 4; ++nb) {
                acc[nb][0] = __builtin_amdgcn_mfma_f32_16x16x32_bf16(a[0], wB[nb][kk], acc[nb][0], 0, 0, 0);
                acc[nb][1] = __builtin_amdgcn_mfma_f32_16x16x32_bf16(a[1], wB[nb][kk], acc[nb][1], 0, 0, 0);
            }
        }
    }
    const int c0 = g * 128 + 32 * wcg + 8 * fq;
#pragma unroll
    for (int nb = 0; nb < 4; ++nb) {
        const int i = 64 * wt + 16 * nb + fr, row = R0 + i;
        const float bs = P.b_s[g * 128 + (smp ? (i & 63) : i)];
        const bf16_t* pr = F.PROJ + (size_t)row * DIN;
        f32x4 u0, u1, g0, g1; unpack8(*(const u32x4*)(pr + C_U + c0), u0, u1); unpack8(*(const u32x4*)(pr + C_GB + c0), g0, g1);
        *(u32x4*)(F.T + (size_t)row * DM + 512 + c0) = pack8((acc[nb][0] + bs) * u0 * g0, (acc[nb][1] + bs) * u1 * g1);
    }
    __syncthreads();
}

__global__ void __launch_bounds__(NTHREADS, 2) fwd_megakernel(Params P) {
    extern __shared__ __attribute__((aligned(16))) unsigned char lds_raw[];
    cg::grid_group grid = cg::this_grid();
    Frame F;
    F.lds = (LAS unsigned char*)lds_raw;
    F.tid = threadIdx.x; F.lane = F.tid & 63; F.wave = __builtin_amdgcn_readfirstlane(F.tid >> 6);
    F.G = gridDim.x; { const int bx = blockIdx.x; F.vcu = (F.G % 8 == 0) ? (bx % 8) * (F.G / 8) + bx / 8 : bx; }
    unsigned char* ws = P.ws;
    F.vstat = (float*)(ws + WS_VSTAT); F.ss = (float*)(ws + WS_SS);
    F.Win_t = (bf16_t*)(ws + WS_WIN); F.Wab_t = (bf16_t*)(ws + WS_WAB); F.Wo_t = (bf16_t*)(ws + WS_WO); F.Wpool_t = (bf16_t*)(ws + WS_WPOOL); F.Ws_b = (bf16_t*)(ws + WS_WSB);
    F.H = (bf16_t*)(ws + WS_H); F.T = (bf16_t*)(ws + WS_T); F.PROJ = (bf16_t*)(ws + WS_PROJ);

    p0_prologue(P, F);
    grid.sync();
    { pg8::Gemm g{F.H, F.Win_t, 1024, 1024, 16, 0, 0}; pg8::Order S; S.init(MTOK, DIN, F.G, (int)blockIdx.x, 1);
      EpiProj E{F.PROJ, F.vstat};
      pg8::gemm_phase<EpiProj, pg8::Order>(F.lds, g, S, E); }
    grid.sync();
    { constexpr int NU = (MTOK / 128) * 8;
      for (int u = (int)blockIdx.x; u < NU; u += F.G) { const int rt = u >> 3, g = (u >> 1) & 3; if (u & 1) sgu_unit(P, F, rt, g); else pool_unit(P, F, rt, g); } }
    grid.sync();
    { pg8::Gemm g{F.T, F.Wab_t, 1024, 1024, 8, 1024, 1024}; pg8::Order S; S.init(MTOK, DM, F.G, (int)blockIdx.x, 2);
      EpiMerge E{F.PROJ, F.H};
      pg8::gemm_phase<EpiMerge, pg8::Order>(F.lds, g, S, E); }
    grid.sync();
    { pg8::Gemm g{F.H, F.Wo_t, 1024, 1024, 16, 0, 0}; pg8::Order S; S.init(MTOK, DM, F.G, (int)blockIdx.x, 1);
      EpiOut E{P.xp, P.xs, P.out, F.ss};
      pg8::gemm_phase<EpiOut, pg8::Order>(F.lds, g, S, E); }
    grid.sync();
    { const int gw = F.vcu * NWAVES + F.wave, NGW = F.G * NWAVES, lane = F.lane;
      f32x4 gv[4];
#pragma unroll
      for (int j = 0; j < 4; ++j) gv[j] = *((const f32x4*)P.final_g + lane + 64 * j);
      for (int m = gw; m < MTOK; m += NGW) {
          f32x4* xr = (f32x4*)(P.out + (size_t)m * DM) + lane;
          const float r = 1.f / sqrtf(F.ss[m] * (1.f / DM) + EPS);
#pragma unroll
          for (int j = 0; j < 4; ++j) xr[64 * j] = xr[64 * j] * r * gv[j];
      } }
}

extern "C" void kernel_launch(void* const* d_in, const int* in_sizes, int n_in, void* d_out, int out_size, void* d_ws, size_t ws_size, hipStream_t stream) {
    static int grid_blocks = 0;
    if (!grid_blocks) {
        int dev = 0, cus = 0, per_cu = 0;
        (void)hipGetDevice(&dev);
        (void)hipDeviceGetAttribute(&cus, hipDeviceAttributeMultiprocessorCount, dev);
        (void)hipFuncSetAttribute((const void*)fwd_megakernel, hipFuncAttributeMaxDynamicSharedMemorySize, LDS_BYTES);
        (void)hipOccupancyMaxActiveBlocksPerMultiprocessor(&per_cu, (const void*)fwd_megakernel, NTHREADS, LDS_BYTES);
        if (per_cu < 1) { fprintf(stderr, "occupancy query says %d blocks/CU; using 1\n", per_cu); per_cu = 1; }
        (void)hipGetLastError();
        grid_blocks = cus * per_cu;
    }
    Params p{};
    p.xp = (const float*)d_in[0]; p.xs = (const float*)d_in[1]; p.cache = (const float*)d_in[2]; p.norm_g = (const float*)d_in[3]; p.w_in = (const float*)d_in[4];
    p.w_pool = (const float*)d_in[5]; p.pool_scale = (const float*)d_in[6]; p.ln_g = (const float*)d_in[7]; p.ln_b = (const float*)d_in[8]; p.w_s = (const float*)d_in[9];
    p.b_s = (const float*)d_in[10]; p.w_a = (const float*)d_in[11]; p.w_b = (const float*)d_in[12]; p.w_o = (const float*)d_in[13]; p.final_g = (const float*)d_in[14];
    p.out = (float*)d_out; p.ws = (unsigned char*)d_ws;
    void* args[] = {&p};
    hipError_t e = hipLaunchCooperativeKernel((const void*)fwd_megakernel, dim3(grid_blocks), dim3(NTHREADS), args, LDS_BYTES, stream);
    if (e != hipSuccess) fprintf(stderr, "cooperative launch failed: %s (grid %d)\n", hipGetErrorString(e), grid_blocks);
}
```

```cpp
#include <hip/hip_runtime.h>
#include <hip/hip_cooperative_groups.h>
#include <cstdio>
#include <cstdint>
namespace cg = cooperative_groups;

#define LAS __attribute__((address_space(3)))
typedef unsigned short bf16_t;
typedef short bf16x8 __attribute__((ext_vector_type(8)));
typedef float f32x4 __attribute__((ext_vector_type(4)));
typedef unsigned u32x4 __attribute__((ext_vector_type(4)));

constexpr int DM = 1024, NP = 4 * 8192, NS = 32 * 64, MTOK = NP + NS, DIN = 4608, SEQ = 8192;
constexpr int C_A = 0, C_GA = 512, C_U = 1024, C_V = 1536, C_GB = 2048, C_RA = 2560, C_RB = 3584;
constexpr float EPS = 1e-6f;
constexpr size_t OUT_YS = (size_t)NP * DM, OUT_SPP = (size_t)MTOK * DM, OUT_SPS = OUT_SPP + 4 * 15 * 512, OUT_SV = OUT_SPS + 32 * 15 * 512;
constexpr size_t MiB = 1u << 20;
constexpr size_t WS_VSTAT = 0, WS_SS = 512 * 1024, WS_BAR = 768 * 1024, WS_BAR_BYTES = 16384, WS_WIN = 1 * MiB, WS_WAB = 10 * MiB, WS_WO = 12 * MiB, WS_WPOOL = 14 * MiB, WS_WSB = 14 * MiB + 131072;
constexpr size_t WS_H = 16 * MiB, WS_T = 84 * MiB, WS_PROJ = 152 * MiB;
constexpr int NWAVES = 8, NTHREADS = 512;
constexpr int LDS_BYTES = 155648;

__device__ __forceinline__ unsigned cvt_pk_bf16(float lo, float hi) { unsigned r; asm volatile("v_cvt_pk_bf16_f32 %0, %1, %2" : "=v"(r) : "v"(lo), "v"(hi)); return r; }
__device__ __forceinline__ float bf_lo(unsigned w) { return __uint_as_float(w << 16); }
__device__ __forceinline__ float bf_hi(unsigned w) { return __uint_as_float(w & 0xffff0000u); }
__device__ __forceinline__ float sigmoidf_fast(float x) { return __builtin_amdgcn_rcpf(1.f + __builtin_amdgcn_exp2f(-1.44269504f * x)); }
__device__ __forceinline__ u32x4 pack8(const f32x4 a, const f32x4 b) { u32x4 w; w.x = cvt_pk_bf16(a[0], a[1]); w.y = cvt_pk_bf16(a[2], a[3]); w.z = cvt_pk_bf16(b[0], b[1]); w.w = cvt_pk_bf16(b[2], b[3]); return w; }
__device__ __forceinline__ void unpack8(const u32x4 w, f32x4& a, f32x4& b) { a = (f32x4){bf_lo(w.x), bf_hi(w.x), bf_lo(w.y), bf_hi(w.y)}; b = (f32x4){bf_lo(w.z), bf_hi(w.z), bf_lo(w.w), bf_hi(w.w)}; }

namespace pg8 {
constexpr int BM = 256, BK = 64, HALF = 128, HTB = HALF * BK * 2, STAGE_BYTES = 8 * HTB, NXCD = 8, WGM = 8;
__host__ __device__ __forceinline__ int lds_byte(int r, int c) { const int st = (r >> 4) * 2 + (c >> 5), rr = r & 15, cc = c & 31, ob = rr * 64 + cc * 2; return st * 1024 + (ob ^ (((ob >> 9) & 1) << 5)); }
__host__ __device__ __forceinline__ void stage_rc(int b, int& R, int& C) { const int st = b / 1024, sb = b % 1024, swz = sb ^ (((sb >> 9) & 1) << 5); R = (st >> 1) * 16 + swz / 64; C = (st & 1) * 32 + (swz % 64) / 2; }
__host__ __device__ __forceinline__ int perm32(int rho) { const int n = rho >> 4, i = rho & 15; return 8 * (i >> 2) + 4 * n + (i & 3); }

struct Unit { int pm, pn, kh; };
struct Gemm { const bf16_t* A; const bf16_t* Bt; int lda, ldb, nt, khA, khB; };

struct Order {
    int nM, nN, nwg, G, c, nkh;
    __device__ void init(int M, int N, int G_, int c_, int nkh_) { nM = M / BM; nN = N / BM; nwg = nM * nN; G = G_; c = c_; nkh = nkh_; }
    __device__ bool next(int i, Unit& u) const {
        const int ti = (nkh == 2) ? (i >> 1) : i; u.kh = (nkh == 2) ? (i & 1) : 0;
        const long L = (long)ti * G + c; if (L >= nwg) return false;
        int wgid = (int)L; { const int q = nwg / NXCD, r = nwg % NXCD, xcd = wgid % NXCD, off = wgid / NXCD; wgid = (xcd < r ? xcd * (q + 1) : r * (q + 1) + (xcd - r) * q) + off; }
        const int nig = WGM * nN, gid = wgid / nig, fm = gid * WGM, gsz = (nM - fm) < WGM ? (nM - fm) : WGM;
        u.pm = fm + ((wgid % nig) % gsz); u.pn = (wgid % nig) / gsz; return true;
    }
};

template <class Epi, class Sched>
__device__ __forceinline__ void gemm_phase(LAS unsigned char* lds, const Gemm g, const Sched& S, const Epi& E, const unsigned delay_ticks) {
    if (delay_ticks) {
        const unsigned long long t0 = __builtin_amdgcn_s_memrealtime();
        while (__builtin_amdgcn_s_memrealtime() - t0 < (unsigned long long)delay_ticks) __builtin_amdgcn_s_sleep(32);
    }
    const int tid = threadIdx.x, wid = __builtin_amdgcn_readfirstlane(tid >> 6), lane = tid & 63, wr = wid >> 2, wc = wid & 3, fr = lane & 15, fq = lane >> 4;
    const int nt = g.nt;
    unsigned voffA[2], voffB[2];
#pragma unroll
    for (int i = 0; i < 2; ++i) { int R, C; stage_rc(tid * 16 + i * 8192, R, C); const int Rb = (R & ~31) + perm32(R & 31);
        voffA[i] = (unsigned)(R * g.lda + C) * 2u; voffB[i] = (unsigned)(Rb * g.ldb + C) * 2u; }
    const size_t kstep = (size_t)(BK * 2);
    const size_t hstepA = (size_t)HALF * g.lda * 2, hstepB = (size_t)HALF * g.ldb * 2;
    const size_t tstepA = 2 * hstepA, tstepB = 2 * hstepB;
    const unsigned ldsw = (unsigned)wid * 1024u;
    const int aoff = lds_byte(wr * 64 + fr, fq * 8), boff = lds_byte(wc * 32 + fr, fq * 8);
#define PG8_SA(b, h) (((b) * 2 + (h)) * HTB)
#define PG8_SB(b, h) ((4 + (b) * 2 + (h)) * HTB)
#define PG8_STAGE(bufoff, gbase, voff) do { _Pragma("unroll") for (int _i = 0; _i < 2; ++_i) \
        __builtin_amdgcn_global_load_lds((const unsigned*)((const char*)(gbase) + (voff)[_i]), (LAS unsigned*)(lds + (bufoff) + ldsw + _i * 8192), 16, 0, 0); } while (0)
#define PG8_LDA(dst, b, h) do { _Pragma("unroll") for (int m = 0; m < 4; ++m) _Pragma("unroll") for (int k = 0; k < 2; ++k) dst[m][k] = *(const LAS bf16x8*)(lds + PG8_SA(b, h) + aoff + m * 2048 + k * 1024); } while (0)
#define PG8_LDB(dst, b, h) do { _Pragma("unroll") for (int n = 0; n < 2; ++n) _Pragma("unroll") for (int k = 0; k < 2; ++k) dst[n][k] = *(const LAS bf16x8*)(lds + PG8_SB(b, h) + boff + n * 2048 + k * 1024); } while (0)
#define PG8_MMA(ai, bj, At, Bt) do { __builtin_amdgcn_s_setprio(1); _Pragma("unroll") for (int m = 0; m < 4; ++m) _Pragma("unroll") for (int n = 0; n < 2; ++n) _Pragma("unroll") for (int k = 0; k < 2; ++k) \
        acc[ai][bj][m][n] = __builtin_amdgcn_mfma_f32_16x16x32_bf16(Bt[n][k], At[m][k], acc[ai][bj][m][n], 0, 0, 0); __builtin_amdgcn_s_setprio(0); } while (0)
#define PG8_WAIT_V(n) asm volatile("s_waitcnt vmcnt(" #n ")" ::: "memory")
#define PG8_WAIT_L(n) asm volatile("s_waitcnt lgkmcnt(" #n ")" ::: "memory")
#define PG8_BAR __builtin_amdgcn_s_barrier()
#define PG8_SCHED __builtin_amdgcn_sched_barrier(0)
#define PG8_ZERO() do { _Pragma("unroll") for (int a = 0; a < 2; ++a) _Pragma("unroll") for (int b = 0; b < 2; ++b) _Pragma("unroll") for (int m = 0; m < 4; ++m) _Pragma("unroll") for (int n = 0; n < 2; ++n) acc[a][b][m][n] = (f32x4){0.f, 0.f, 0.f, 0.f}; } while (0)
    Unit cur, nxt; int ui = 0;
    if (!S.next(0, cur)) return;
    f32x4 acc[2][2][4][2];
    PG8_ZERO();
    bf16x8 At[4][2], B0[2][2], B1[2][2];
    const char* cA = (const char*)g.A + (size_t)cur.pm * tstepA + (size_t)cur.kh * g.khA; const char* cB = (const char*)g.Bt + (size_t)cur.pn * tstepB + (size_t)cur.kh * g.khB;
    PG8_STAGE(PG8_SB(0, 0), cB, voffB); PG8_STAGE(PG8_SB(0, 1), cB + hstepB, voffB); PG8_STAGE(PG8_SA(0, 0), cA, voffA); PG8_STAGE(PG8_SA(0, 1), cA + hstepA, voffA);
    if (wr == 1) PG8_BAR;
    PG8_WAIT_V(2); PG8_BAR;
    PG8_STAGE(PG8_SB(1, 0), cB + kstep, voffB); PG8_STAGE(PG8_SA(1, 0), cA + kstep, voffA); PG8_STAGE(PG8_SB(1, 1), cB + hstepB + kstep, voffB);
    PG8_WAIT_V(6); PG8_BAR;
    for (;;) {
        const bool has_next = S.next(ui + 1, nxt);
        const char* nA = has_next ? (const char*)g.A + (size_t)nxt.pm * tstepA + (size_t)nxt.kh * g.khA : cA; const char* nB = has_next ? (const char*)g.Bt + (size_t)nxt.pn * tstepB + (size_t)nxt.kh * g.khB : cB;
        for (int t = 0; t < nt; t += 2) {
            const bool last = (t == nt - 2);
            const char* a1 = cA + (size_t)(t + 1) * kstep;
            const char* a2 = last ? nA : cA + (size_t)(t + 2) * kstep; const char* b2 = last ? nB : cB + (size_t)(t + 2) * kstep;
            const char* a3 = a2 + kstep; const char* b3 = b2 + kstep;
            PG8_LDB(B0, 0, 0); PG8_LDB(B1, 0, 1); PG8_SCHED; PG8_LDA(At, 0, 0); PG8_STAGE(PG8_SA(1, 1), a1 + hstepA, voffA);
            PG8_WAIT_V(8); PG8_WAIT_L(0); PG8_BAR; PG8_MMA(0, 0, At, B0); PG8_MMA(0, 1, At, B1); PG8_BAR; PG8_SCHED;
            PG8_LDA(At, 0, 1); PG8_STAGE(PG8_SB(0, 0), b2, voffB); PG8_STAGE(PG8_SB(0, 1), b2 + hstepB, voffB); PG8_STAGE(PG8_SA(0, 0), a2, voffA);
            PG8_WAIT_V(8); PG8_WAIT_L(0); PG8_BAR; PG8_MMA(1, 0, At, B0); PG8_MMA(1, 1, At, B1); PG8_BAR; PG8_SCHED;
            PG8_LDB(B0, 1, 0); PG8_LDB(B1, 1, 1); PG8_SCHED; PG8_LDA(At, 1, 0); PG8_STAGE(PG8_SA(0, 1), a2 + hstepA, voffA);
            PG8_WAIT_V(8); PG8_WAIT_L(0); PG8_BAR; PG8_MMA(0, 0, At, B0); PG8_MMA(0, 1, At, B1); PG8_BAR; PG8_SCHED;
            PG8_LDA(At, 1, 1); PG8_STAGE(PG8_SB(1, 0), b3, voffB); PG8_STAGE(PG8_SB(1, 1), b3 + hstepB, voffB); PG8_STAGE(PG8_SA(1, 0), a3, voffA);
            PG8_WAIT_V(8); PG8_WAIT_L(0); PG8_BAR; PG8_MMA(1, 0, At, B0); PG8_MMA(1, 1, At, B1); PG8_BAR; PG8_SCHED;
        }
        if (wr == 0) PG8_BAR;
        E(acc, cur, wr, wc, fr, fq);
        if (!has_next) break;
        if (!Epi::keep(cur)) PG8_ZERO();
        cur = nxt; cA = nA; cB = nB; ++ui;
        if (wr == 1) PG8_BAR;
    }
    PG8_WAIT_V(0);
    PG8_BAR;
#undef PG8_SA
#undef PG8_SB
#undef PG8_STAGE
#undef PG8_LDA
#undef PG8_LDB
#undef PG8_MMA
#undef PG8_WAIT_V
#undef PG8_WAIT_L
#undef PG8_BAR
#undef PG8_SCHED
#undef PG8_ZERO
}
}
using pg8::Unit;

struct EpiProj {
    bf16_t* proj; float* vstat;
    static __device__ __forceinline__ bool keep(const Unit&) { return false; }
    __device__ __forceinline__ void operator()(f32x4 (&acc)[2][2][4][2], const Unit& u, int wr, int wc, int fr, int fq) const {
        const int row0 = u.pm * 256 + wr * 64 + fr, col0 = u.pn * 256 + wc * 32 + 8 * fq;
        const int pn = u.pn;
        const int kind = (pn >= 10) ? 2 : ((pn == 2 || pn == 3 || pn == 8 || pn == 9) ? 1 : ((pn == 6 || pn == 7) ? 3 : 0));
#pragma unroll
        for (int ai = 0; ai < 2; ++ai)
#pragma unroll
            for (int m = 0; m < 4; ++m) {
                const int row = row0 + ai * 128 + m * 16;
                bf16_t* rowp = proj + (size_t)row * DIN + col0;
                float s1 = 0.f, s2 = 0.f;
#pragma unroll
                for (int bj = 0; bj < 2; ++bj) {
                    f32x4 v0 = acc[ai][bj][m][0], v1 = acc[ai][bj][m][1];
                    if (kind == 1) {
#pragma unroll
                        for (int e = 0; e < 4; ++e) { v0[e] = v0[e] * sigmoidf_fast(v0[e]); v1[e] = v1[e] * sigmoidf_fast(v1[e]); }
                    } else if (kind == 2) {
#pragma unroll
                        for (int e = 0; e < 4; ++e) { v0[e] = sigmoidf_fast(v0[e]); v1[e] = sigmoidf_fast(v1[e]); }
                    } else if (kind == 3) {
#pragma unroll
                        for (int e = 0; e < 4; ++e) { s1 += v0[e] + v1[e]; s2 += v0[e] * v0[e] + v1[e] * v1[e]; }
                    }
                    *(u32x4*)(rowp + bj * 128) = pack8(v0, v1);
                }
                if (kind == 3) {
                    s1 += __shfl_xor(s1, 16); s1 += __shfl_xor(s1, 32); s2 += __shfl_xor(s2, 16); s2 += __shfl_xor(s2, 32);
                    if (fq == 0) { atomicAdd(vstat + 2 * row, s1); atomicAdd(vstat + 2 * row + 1, s2); }
                }
            }
    }
};
struct EpiMerge {
    const bf16_t* proj; bf16_t* outm;
    static __device__ __forceinline__ bool keep(const Unit& u) { return u.kh == 0; }
    __device__ __forceinline__ void operator()(f32x4 (&acc)[2][2][4][2], const Unit& u, int wr, int wc, int fr, int fq) const {
        const int row0 = u.pm * 256 + wr * 64 + fr, col0 = u.pn * 256 + wc * 32 + 8 * fq;
        if (u.kh == 0) {
#pragma unroll
            for (int ai = 0; ai < 2; ++ai) {
                u32x4 sb[4][2], sa[4][2];
#pragma unroll
                for (int m = 0; m < 4; ++m)
#pragma unroll
                    for (int bj = 0; bj < 2; ++bj) {
                        const bf16_t* pr = proj + (size_t)(row0 + ai * 128 + m * 16) * DIN + col0 + bj * 128;
                        sb[m][bj] = *(const u32x4*)(pr + C_RB); sa[m][bj] = *(const u32x4*)(pr + C_RA);
                    }
                __builtin_amdgcn_sched_barrier(0);
#pragma unroll
                for (int m = 0; m < 4; ++m)
#pragma unroll
                    for (int bj = 0; bj < 2; ++bj) {
                        f32x4 b0, b1, a0, a1; unpack8(sb[m][bj], b0, b1); unpack8(sa[m][bj], a0, a1);
#pragma unroll
                        for (int e = 0; e < 4; ++e) { acc[ai][bj][m][0][e] *= a0[e] * __builtin_amdgcn_rcpf(b0[e]); acc[ai][bj][m][1][e] *= a1[e] * __builtin_amdgcn_rcpf(b1[e]); }
                    }
                __builtin_amdgcn_sched_barrier(0);
            }
        } else {
            u32x4 sb[2][4][2];
#pragma unroll
            for (int ai = 0; ai < 2; ++ai)
#pragma unroll
                for (int m = 0; m < 4; ++m)
#pragma unroll
                    for (int bj = 0; bj < 2; ++bj)
                        sb[ai][m][bj] = *(const u32x4*)(proj + (size_t)(row0 + ai * 128 + m * 16) * DIN + col0 + bj * 128 + C_RB);
            __builtin_amdgcn_sched_barrier(0);
#pragma unroll
            for (int ai = 0; ai < 2; ++ai)
#pragma unroll
                for (int m = 0; m < 4; ++m)
#pragma unroll
                    for (int bj = 0; bj < 2; ++bj) {
                        const int row = row0 + ai * 128 + m * 16, c = col0 + bj * 128;
                        f32x4 b0, b1; unpack8(sb[ai][m][bj], b0, b1);
                        *(u32x4*)(outm + (size_t)row * DM + c) = pack8(acc[ai][bj][m][0] * b0, acc[ai][bj][m][1] * b1);
                    }
            __builtin_amdgcn_sched_barrier(0);
        }
    }
};
struct EpiOut {
    const float* xp; const float* xs; float* out; float* ss;
    static __device__ __forceinline__ bool keep(const Unit&) { return false; }
    __device__ __forceinline__ void operator()(f32x4 (&acc)[2][2][4][2], const Unit& u, int wr, int wc, int fr, int fq) const {
        const int row0 = u.pm * 256 + wr * 64 + fr, col0 = u.pn * 256 + wc * 32 + 8 * fq;
        const float* xbase = (u.pm * 256 < NP) ? xp : xs - (size_t)NP * DM;
#pragma unroll
        for (int ai = 0; ai < 2; ++ai) {
            f32x4 xv[4][2][2];
#pragma unroll
            for (int m = 0; m < 4; ++m)
#pragma unroll
                for (int bj = 0; bj < 2; ++bj) {
                    const float* xr = xbase + (size_t)(row0 + ai * 128 + m * 16) * DM + col0 + bj * 128;
                    xv[m][bj][0] = *(const f32x4*)xr; xv[m][bj][1] = *(const f32x4*)(xr + 4);
                }
            __builtin_amdgcn_sched_barrier(0);
#pragma unroll
            for (int m = 0; m < 4; ++m) {
                const int row = row0 + ai * 128 + m * 16;
                float* orow = out + (size_t)row * DM;
                float q = 0.f;
#pragma unroll
                for (int bj = 0; bj < 2; ++bj) {
                    const int c = col0 + bj * 128;
                    const f32x4 o0 = xv[m][bj][0] + acc[ai][bj][m][0], o1 = xv[m][bj][1] + acc[ai][bj][m][1];
                    *(f32x4*)(orow + c) = o0; *(f32x4*)(orow + c + 4) = o1;
                    q += (o0[0] * o0[0] + o0[1] * o0[1]) + (o0[2] * o0[2] + o0[3] * o0[3]) + (o1[0] * o1[0] + o1[1] * o1[1]) + (o1[2] * o1[2] + o1[3] * o1[3]);
                }
                q += __shfl_xor(q, 16); q += __shfl_xor(q, 32);
                if (fq == 0) atomicAdd(ss + row, q);
            }
            __builtin_amdgcn_sched_barrier(0);
        }
    }
};

struct Params {
    const float *xp, *xs, *cache, *norm_g, *w_in, *w_pool, *pool_scale, *ln_g, *ln_b, *w_s, *b_s, *w_a, *w_b, *w_o, *final_g;
    float* out; unsigned char* ws;
};
struct Frame {
    LAS unsigned char* lds; int tid, lane, wave, vcu, G;
    bf16_t *Win_t, *Wab_t, *Wo_t, *Wpool_t, *Ws_b, *H, *T, *PROJ;
    float *vstat, *ss;
};
#define LDS_WAIT() asm volatile("s_waitcnt lgkmcnt(0)" ::: "memory")
__device__ __forceinline__ float wave_sum(float v) {
#pragma unroll
    for (int o = 1; o < 64; o <<= 1) v += __shfl_xor(v, o);
    return v;
}
__device__ __forceinline__ void transpose_item(const float* W, int N, bf16_t* WT, int ldt, LAS float* scr, int item, int nblk, int lane) {
    const int kb = item / nblk, nb = item % nblk, k0 = 64 * kb, n0 = 32 * nb;
#pragma unroll 8
    for (int i = 0; i < 32; ++i) { const int kk = 2 * i + (lane >> 5); scr[kk * 33 + (lane & 31)] = W[(size_t)(k0 + kk) * N + n0 + (lane & 31)]; }
    LDS_WAIT(); asm volatile("" ::: "memory");
    const int c = lane & 7;
#pragma unroll
    for (int j = 0; j < 4; ++j) { const int n = (lane >> 3) + 8 * j; const LAS float* s = scr + (8 * c) * 33 + n;
        u32x4 o; o.x = cvt_pk_bf16(s[0 * 33], s[1 * 33]); o.y = cvt_pk_bf16(s[2 * 33], s[3 * 33]); o.z = cvt_pk_bf16(s[4 * 33], s[5 * 33]); o.w = cvt_pk_bf16(s[6 * 33], s[7 * 33]);
        *(u32x4*)(WT + (size_t)(n0 + n) * ldt + k0 + 8 * c) = o; }
    LDS_WAIT(); asm volatile("" ::: "memory");
}

__device__ __forceinline__ void p0_prologue(const Params& P, Frame& F) {
    LAS float* scr = (LAS float*)(F.lds + F.wave * 16384);
    const int gw = F.vcu * NWAVES + F.wave, NGW = F.G * NWAVES, lane = F.lane;
    constexpr int I_IN = 16 * 144, I_A = 8 * 32, I_O = 16 * 32, I_P = 2 * 4;
    constexpr int NITEMS = I_IN + 2 * I_A + I_O + 4 * I_P;
    for (int it = gw; it < NITEMS; it += NGW) {
        int r = it;
        if (r < I_IN) { transpose_item(P.w_in, DIN, F.Win_t, 1024, scr, r, 144, lane); continue; } r -= I_IN;
        if (r < I_A) { transpose_item(P.w_a, 1024, F.Wab_t, 1024, scr, r, 32, lane); continue; } r -= I_A;
        if (r < I_A) { transpose_item(P.w_b, 1024, F.Wab_t + 512, 1024, scr, r, 32, lane); continue; } r -= I_A;
        if (r < I_O) { transpose_item(P.w_o, 1024, F.Wo_t, 1024, scr, r, 32, lane); continue; } r -= I_O;
        { const int g = r / I_P; transpose_item(P.w_pool + g * 16384, 128, F.Wpool_t + g * 16384, 128, scr, r % I_P, 4, lane); }
    }
    const int gt = F.vcu * NTHREADS + F.tid, NGT = F.G * NTHREADS;
    for (int e = gt; e < 4 * 128 * 128 / 2; e += NGT) { const int i = (e >> 6) & 127, j = (e & 63) * 2; const float lo = P.w_s[2 * e], hi = P.w_s[2 * e + 1]; const bool z = (i < 64 && j >= 64);
        ((unsigned*)F.Ws_b)[e] = z ? 0u : cvt_pk_bf16(lo, hi); }
    for (int e = gt; e < MTOK * 2; e += NGT) F.vstat[e] = 0.f;
    for (int e = gt; e < MTOK; e += NGT) F.ss[e] = 0.f;
    f32x4 gv[4];
#pragma unroll
    for (int j = 0; j < 4; ++j) gv[j] = *((const f32x4*)P.norm_g + lane + 64 * j);
    for (int m0 = gw; m0 < MTOK; m0 += 4 * NGW) {
        f32x4 v[4][4];
#pragma unroll
        for (int q = 0; q < 4; ++q) { const int m = m0 + q * NGW; if (m < MTOK) {
            const float* xrow = (m < NP) ? P.xp + (size_t)m * DM : P.xs + (size_t)(m - NP) * DM;
#pragma unroll
            for (int j = 0; j < 4; ++j) v[q][j] = ((const f32x4*)xrow)[lane + 64 * j]; } }
#pragma unroll
        for (int q = 0; q < 4; ++q) { const int m = m0 + q * NGW; if (m < MTOK) {
            float s = 0.f;
#pragma unroll
            for (int j = 0; j < 4; ++j) s += (v[q][j].x * v[q][j].x + v[q][j].y * v[q][j].y) + (v[q][j].z * v[q][j].z + v[q][j].w * v[q][j].w);
            const float r = 1.f / sqrtf(wave_sum(s) * (1.f / DM) + EPS);
            unsigned long long* o8 = (unsigned long long*)(F.H + (size_t)m * DM) + lane;
#pragma unroll
            for (int j = 0; j < 4; ++j) { const f32x4 h = v[q][j] * r * gv[j]; o8[64 * j] = (unsigned long long)cvt_pk_bf16(h.x, h.y) | ((unsigned long long)cvt_pk_bf16(h.z, h.w) << 32); } } }
    }
}

__device__ __forceinline__ void pool_unit(const Params& P, Frame& F, int rt, int g) {
    const int tid = F.tid, lane = F.lane, fr = lane & 15, fq = lane >> 4, wd = F.wave & 3, wt = F.wave >> 2;
    const int R0 = rt * 128; const bool smp = R0 >= NP;
    LAS float* aT = (LAS float*)F.lds;
    LAS bf16_t* PA = (LAS bf16_t*)(F.lds + 81920);
    bf16x8 wA[2][4];
    { const bf16_t* wp = F.Wpool_t + g * 16384;
#pragma unroll
      for (int n = 0; n < 2; ++n) { const int d = 32 * wd + 8 * (fr >> 2) + 4 * n + (fr & 3);
#pragma unroll
        for (int kk = 0; kk < 4; ++kk) wA[n][kk] = *(const bf16x8*)(wp + d * 128 + kk * 32 + fq * 8); } }
    const int d0 = g * 128 + 32 * wd + 8 * fq;
    const f32x4 ps0 = *(const f32x4*)(P.pool_scale + d0), ps1 = *(const f32x4*)(P.pool_scale + d0 + 4);
    u32x4 gate[4];
#pragma unroll
    for (int nb = 0; nb < 4; ++nb) gate[nb] = *(const u32x4*)(F.PROJ + (size_t)(R0 + 64 * wt + 16 * nb + fr) * DIN + C_GA + d0);
#pragma unroll
    for (int q = 0; q < 5; ++q) {
        const int p = tid + 512 * q, seg = p / 1280, rem = p - seg * 1280, r = rem >> 4, cb = rem & 15, rel = r - 16;
        const int segrow = R0 + 64 * seg;
        f32x4 lo = (f32x4){0.f, 0.f, 0.f, 0.f}, hi = lo;
        if (rel >= 0 || (!smp && (segrow & (SEQ - 1)) != 0)) {
            unpack8(*(const u32x4*)(F.PROJ + (size_t)(segrow + rel) * DIN + C_A + g * 128 + cb * 8), lo, hi);
        } else if (smp && rel >= -15) {
            const int s = (segrow - NP) >> 6; const float* cp = P.cache + ((size_t)s * 15 + (15 + rel)) * 512 + g * 128 + cb * 8;
            lo = *(const f32x4*)cp; hi = *(const f32x4*)(cp + 4);
        }
        LAS float* dst = aT + (seg * 80 + r) * 128 + cb * 8;
        *(LAS f32x4*)dst = lo; *(LAS f32x4*)(dst + 4) = hi;
    }
    __syncthreads();
    {
        const int c = tid & 127, q = tid >> 7, seg = q >> 1, k0 = 32 * (q & 1), w = 2 << g;
        const int segrow = R0 + 64 * seg, tpos0 = segrow & (SEQ - 1);
        const LAS float* base = aT + (seg * 80 + 16) * 128 + c;
        float S = 0.f;
        for (int d = 1; d < w; ++d) S += base[(k0 - d) * 128];
        const float invw = 1.f / (float)w;
        for (int k = k0; k < k0 + 32; ++k) {
            const float a = base[k * 128]; S += a;
            float inv = invw;
            if (!smp) { const int t = tpos0 + k; if (t + 1 < w) inv = 1.f / (float)(t + 1); }
            const float o = S * inv - a;
            PA[(64 * seg + k) * 136 + c] = (bf16_t)(cvt_pk_bf16(o, 0.f) & 0xffffu);
            S -= base[(k - w + 1) * 128];
            if (!smp) { const int t = tpos0 + k; if (t >= SEQ - 15) P.out[OUT_SPP + ((size_t)(R0 >> 13) * 15 + (t - (SEQ - 15))) * 512 + g * 128 + c] = a; }
            else if (k >= 49) { const int s = (segrow - NP) >> 6; P.out[OUT_SPS + ((size_t)s * 15 + (k - 49)) * 512 + g * 128 + c] = a; }
        }
    }
    __syncthreads();
    f32x4 acc[4][2];
#pragma unroll
    for (int nb = 0; nb < 4; ++nb) { acc[nb][0] = (f32x4){0.f, 0.f, 0.f, 0.f}; acc[nb][1] = acc[nb][0]; }
#pragma unroll
    for (int nb = 0; nb < 4; ++nb) {
        const LAS bf16_t* pr = PA + (64 * wt + 16 * nb + fr) * 136 + fq * 8;
#pragma unroll
        for (int kk = 0; kk < 4; ++kk) {
            const bf16x8 b = *(const LAS bf16x8*)(pr + kk * 32);
            acc[nb][0] = __builtin_amdgcn_mfma_f32_16x16x32_bf16(wA[0][kk], b, acc[nb][0], 0, 0, 0);
            acc[nb][1] = __builtin_amdgcn_mfma_f32_16x16x32_bf16(wA[1][kk], b, acc[nb][1], 0, 0, 0);
        }
    }
#pragma unroll
    for (int nb = 0; nb < 4; ++nb) {
        const int row = R0 + 64 * wt + 16 * nb + fr;
        f32x4 s0, s1; unpack8(gate[nb], s0, s1);
        *(u32x4*)(F.T + (size_t)row * DM + d0) = pack8(acc[nb][0] * ps0 * s0, acc[nb][1] * ps1 * s1);
    }
    __syncthreads();
}
__device__ __forceinline__ void sgu_unit(const Params& P, Frame& F, int rt, int g) {
    const int tid = F.tid, lane = F.lane, fr = lane & 15, fq = lane >> 4, wcg = F.wave & 3, wt = F.wave >> 2;
    const int R0 = rt * 128; const bool smp = R0 >= NP;
    LAS bf16_t* VH = (LAS bf16_t*)(F.lds + 116736);
    const bool k_lo = (wt == 0) || !smp, k_hi = (wt == 1);
    bf16x8 wB[4][4];
    { const bf16_t* wp = F.Ws_b + g * 16384;
#pragma unroll
      for (int nb = 0; nb < 4; ++nb) { const int i = 64 * wt + 16 * nb + fr;
#pragma unroll
        for (int kk = 0; kk < 4; ++kk) {
            const bool need = (kk < 2) ? k_lo : k_hi;
            const bf16_t* src = (smp && wt == 1) ? wp + (i - 64) * 128 + (kk * 32 - 64) + fq * 8 : wp + i * 128 + kk * 32 + fq * 8;
            if (need) wB[nb][kk] = *(const bf16x8*)src; else wB[nb][kk] = (bf16x8){0, 0, 0, 0, 0, 0, 0, 0};
        } } }
    const int c0 = g * 128 + 32 * wcg + 8 * fq;
    u32x4 gu[4], gg[4]; float bsv[4];
#pragma unroll
    for (int nb = 0; nb < 4; ++nb) { const int i = 64 * wt + 16 * nb + fr; const bf16_t* pr = F.PROJ + (size_t)(R0 + i) * DIN;
        gu[nb] = *(const u32x4*)(pr + C_U + c0); gg[nb] = *(const u32x4*)(pr + C_GB + c0); bsv[nb] = P.b_s[g * 128 + (smp ? (i & 63) : i)]; }
    {
        const int cb = tid & 15;
        const f32x4 lg0 = *(const f32x4*)(P.ln_g + g * 128 + cb * 8), lg1 = *(const f32x4*)(P.ln_g + g * 128 + cb * 8 + 4);
        const f32x4 lb0 = *(const f32x4*)(P.ln_b + g * 128 + cb * 8), lb1 = *(const f32x4*)(P.ln_b + g * 128 + cb * 8 + 4);
#pragma unroll
        for (int q = 0; q < 4; ++q) {
            const int j = (tid >> 4) + 32 * q, row = R0 + j;
            f32x4 v0, v1; unpack8(*(const u32x4*)(F.PROJ + (size_t)row * DIN + C_V + g * 128 + cb * 8), v0, v1);
            const float s1 = F.vstat[2 * row], s2 = F.vstat[2 * row + 1];
            const float mean = s1 * (1.f / 512.f), var = fmaxf(s2 * (1.f / 512.f) - mean * mean, 0.f), rstd = 1.f / sqrtf(var + EPS);
            v0 = (v0 - mean) * rstd * lg0 + lb0; v1 = (v1 - mean) * rstd * lg1 + lb1;
            if (smp) { float* o = P.out + OUT_SV + (size_t)(row - NP) * 512 + g * 128 + cb * 8; *(f32x4*)o = v0; *(f32x4*)(o + 4) = v1; }
            *(LAS u32x4*)(VH + j * 136 + cb * 8) = pack8(v0, v1);
        }
    }
    __syncthreads();
    f32x4 acc[4][2];
#pragma unroll
    for (int nb = 0; nb < 4; ++nb) { acc[nb][0] = (f32x4){0.f, 0.f, 0.f, 0.f}; acc[nb][1] = acc[nb][0]; }
#pragma unroll
    for (int kk = 0; kk < 4; ++kk) {
        const bool need = (kk < 2) ? k_lo : k_hi;
        if (need) {
            bf16x8 a[2];
#pragma unroll
            for (int n = 0; n < 2; ++n) { const int c = 32 * wcg + 8 * (fr >> 2) + 4 * n + (fr & 3); const LAS bf16_t* vp = VH + (kk * 32 + fq * 8) * 136 + c;
#pragma unroll
                for (int e = 0; e < 8; ++e) a[n][e] = (short)vp[e * 136]; }
#pragma unroll
            for (int nb = 0; nb < 4; ++nb) {
                acc[nb][0] = __builtin_amdgcn_mfma_f32_16x16x32_bf16(a[0], wB[nb][kk], acc[nb][0], 0, 0, 0);
                acc[nb][1] = __builtin_amdgcn_mfma_f32_16x16x32_bf16(a[1], wB[nb][kk], acc[nb][1], 0, 0, 0);
            }
        }
    }
#pragma unroll
    for (int nb = 0; nb < 4; ++nb) {
        const int i = 64 * wt + 16 * nb + fr, row = R0 + i;
        const float bs = bsv[nb];
        f32x4 u0, u1, g0, g1; unpack8(gu[nb], u0, u1); unpack8(gg[nb], g0, g1);
        *(u32x4*)(F.T + (size_t)row * DM + 512 + c0) = pack8((acc[nb][0] + bs) * u0 * g0, (acc[nb][1] + bs) * u1 * g1);
    }
    __syncthreads();
}


#define XB_TMO      128
#define XB_XCNT(j)  (256  + 64 * (j))
#define XB_XSUB(j)  (1280 + 64 * (j))
#define XB_XGEN(j)  (2304 + 64 * (j))
#define XB_TOP      3328
#define XB_TOPGEN   3392
#define XCD_BAR_WORDS 3456
#define XB_SPIN_CAP (1u << 18)
__device__ __forceinline__ unsigned xb_ld(unsigned* p)              { return __hip_atomic_load(p, __ATOMIC_RELAXED, __HIP_MEMORY_SCOPE_AGENT); }
__device__ __forceinline__ unsigned xb_add(unsigned* p, unsigned v) { return __hip_atomic_fetch_add(p, v, __ATOMIC_RELAXED, __HIP_MEMORY_SCOPE_AGENT); }
__device__ __forceinline__ unsigned xb_xcc_id() { return (unsigned)__builtin_amdgcn_s_getreg((3 << 11) | 20) & 0xFu; }
#define XB_SPIN(cond, bar) do { unsigned _sp = 0; while (cond) { __builtin_amdgcn_s_sleep(1); \
    if ((++_sp & 255u) == 0u) { if (xb_ld(&(bar)[XB_TMO])) break; if (_sp > XB_SPIN_CAP) { atomicAdd(&(bar)[XB_TMO], 1u); break; } } } } while (0)
struct XcdBarrier { unsigned* bar; unsigned x; volatile LAS unsigned* st; };
__device__ __forceinline__ XcdBarrier xcd_barrier_post(unsigned* bar, volatile LAS unsigned* st) {
    XcdBarrier b; b.bar = bar; b.x = xb_xcc_id(); b.st = st;
    if (threadIdx.x == 0) (void)xb_add(&bar[XB_XCNT(b.x)], 1u);
    return b;
}
__device__ __forceinline__ void xcd_barrier_complete(unsigned* bar, unsigned x, unsigned& nloc, unsigned& nx) {
    const unsigned G = gridDim.x * gridDim.y * gridDim.z;
    unsigned sum, cnt, mine, sp = 0u;
    for (;;) {
        sum = 0u; cnt = 0u; mine = 0u;
#pragma unroll
        for (unsigned j = 0; j < 16; ++j) { const unsigned c = xb_ld(&bar[XB_XCNT(j)]); sum += c; cnt += (c > 0u) ? 1u : 0u; mine = (j == x) ? c : mine; }
        if (sum == G) break;
        __builtin_amdgcn_s_sleep(1);
        if ((++sp & 255u) == 0u) { if (xb_ld(&bar[XB_TMO])) break; if (sp > XB_SPIN_CAP) { atomicAdd(&bar[XB_TMO], 1u); break; } }
    }
    nloc = mine > 0u ? mine : 1u; nx = cnt > 0u ? cnt : 1u;
}
__device__ __forceinline__ void xcd_barrier(const XcdBarrier& b) {
    asm volatile("s_waitcnt vmcnt(0)" ::: "memory");
    __syncthreads();
    if (threadIdx.x == 0) {
        unsigned* bar = b.bar;
        __builtin_amdgcn_s_waitcnt(0);
        unsigned nloc = b.st[0], nx = b.st[1];
        if (nloc == 0u) { xcd_barrier_complete(bar, b.x, nloc, nx); b.st[0] = nloc; b.st[1] = nx; }
        const unsigned old = xb_add(&bar[XB_XSUB(b.x)], 1u);
        const unsigned gen = old / nloc;
        if (old + 1u == (gen + 1u) * nloc) {
            __builtin_amdgcn_fence(__ATOMIC_RELEASE, "agent");
            asm volatile("s_waitcnt vmcnt(0)" ::: "memory");
            const unsigned og = xb_add(&bar[XB_TOP], 1u);
            const unsigned tg = og / nx;
            if (og + 1u == (tg + 1u) * nx) xb_add(&bar[XB_TOPGEN], 1u);
            else XB_SPIN(xb_ld(&bar[XB_TOPGEN]) == tg, bar);
            __builtin_amdgcn_fence(__ATOMIC_ACQUIRE, "agent");
            xb_add(&bar[XB_XGEN(b.x)], 1u);
            asm volatile("s_waitcnt vmcnt(0)" ::: "memory");
        } else {
            XB_SPIN(xb_ld(&bar[XB_XGEN(b.x)]) == gen, bar);
            __builtin_amdgcn_fence(__ATOMIC_ACQUIRE, "agent");
            asm volatile("s_waitcnt vmcnt(0)" ::: "memory");
        }
    }
    __syncthreads();
}

__global__ void __launch_bounds__(NTHREADS, 2) fwd_megakernel(Params P) {
    extern __shared__ __attribute__((aligned(16))) unsigned char lds_raw[];
    cg::grid_group grid = cg::this_grid();
    Frame F;
    F.lds = (LAS unsigned char*)lds_raw;
    F.tid = threadIdx.x; F.lane = F.tid & 63; F.wave = __builtin_amdgcn_readfirstlane(F.tid >> 6);
    F.G = gridDim.x; { const int bx = blockIdx.x; F.vcu = (F.G % 8 == 0) ? (bx % 8) * (F.G / 8) + bx / 8 : bx; }
    unsigned char* ws = P.ws;
    F.vstat = (float*)(ws + WS_VSTAT); F.ss = (float*)(ws + WS_SS);
    F.Win_t = (bf16_t*)(ws + WS_WIN); F.Wab_t = (bf16_t*)(ws + WS_WAB); F.Wo_t = (bf16_t*)(ws + WS_WO); F.Wpool_t = (bf16_t*)(ws + WS_WPOOL); F.Ws_b = (bf16_t*)(ws + WS_WSB);
    F.H = (bf16_t*)(ws + WS_H); F.T = (bf16_t*)(ws + WS_T); F.PROJ = (bf16_t*)(ws + WS_PROJ);

    volatile LAS unsigned* bst = (volatile LAS unsigned*)(F.lds + 151552);
    if (F.tid < 2) bst[F.tid] = 0u;
    __syncthreads();
    const XcdBarrier xbar = xcd_barrier_post((unsigned*)(ws + WS_BAR), bst);
    p0_prologue(P, F);
    grid.sync();
    { pg8::Gemm g{F.H, F.Win_t, 1024, 1024, 16, 0, 0}; pg8::Order S; S.init(MTOK, DIN, F.G, (int)blockIdx.x, 1);
      EpiProj E{F.PROJ, F.vstat};
      const int c = (int)blockIdx.x, grp = ((c >> 3) & 1) + (c >= 144 ? 2 : 0);
      pg8::gemm_phase<EpiProj, pg8::Order>(F.lds, g, S, E, 0u); }
    xcd_barrier(xbar);
    { constexpr int NU = (MTOK / 128) * 8;
      for (int u = (int)blockIdx.x; u < NU; u += F.G) { const int rt = u >> 3, g = (u >> 1) & 3; if (u & 1) sgu_unit(P, F, rt, g); else pool_unit(P, F, rt, g); } }
    xcd_barrier(xbar);
    { pg8::Gemm g{F.T, F.Wab_t, 1024, 1024, 8, 1024, 1024}; pg8::Order S; S.init(MTOK, DM, F.G, (int)blockIdx.x, 2);
      EpiMerge E{F.PROJ, F.H};
      const int c = (int)blockIdx.x, grp = (c < 32) ? 0 : 1 + ((c >> 3) & 3);
      pg8::gemm_phase<EpiMerge, pg8::Order>(F.lds, g, S, E, 0u); }
    xcd_barrier(xbar);
    { pg8::Gemm g{F.H, F.Wo_t, 1024, 1024, 16, 0, 0}; pg8::Order S; S.init(MTOK, DM, F.G, (int)blockIdx.x, 1);
      EpiOut E{P.xp, P.xs, P.out, F.ss};
      const int c = (int)blockIdx.x, grp = (c < 32) ? 0 : 1 + ((c >> 3) & 3);
      pg8::gemm_phase<EpiOut, pg8::Order>(F.lds, g, S, E, 0u); }
    xcd_barrier(xbar);
    { const int gw = F.vcu * NWAVES + F.wave, NGW = F.G * NWAVES, lane = F.lane;
      f32x4 gv[4];
#pragma unroll
      for (int j = 0; j < 4; ++j) gv[j] = *((const f32x4*)P.final_g + lane + 64 * j);
      for (int m0 = gw; m0 < MTOK; m0 += 4 * NGW) {
          f32x4 v[4][4]; float r[4];
#pragma unroll
          for (int q = 0; q < 4; ++q) { const int m = m0 + q * NGW; if (m < MTOK) {
              const f32x4* xr = (const f32x4*)(P.out + (size_t)m * DM) + lane; r[q] = F.ss[m];
#pragma unroll
              for (int j = 0; j < 4; ++j) v[q][j] = xr[64 * j]; } }
#pragma unroll
          for (int q = 0; q < 4; ++q) { const int m = m0 + q * NGW; if (m < MTOK) {
              f32x4* xr = (f32x4*)(P.out + (size_t)m * DM) + lane; const float rr = 1.f / sqrtf(r[q] * (1.f / DM) + EPS);
#pragma unroll
              for (int j = 0; j < 4; ++j) xr[64 * j] = v[q][j] * rr * gv[j]; } }
      } }
}

extern "C" void kernel_launch(void* const* d_in, const int* in_sizes, int n_in, void* d_out, int out_size, void* d_ws, size_t ws_size, hipStream_t stream) {
    static int grid_blocks = 0;
    if (!grid_blocks) {
        int dev = 0, cus = 0, per_cu = 0;
        (void)hipGetDevice(&dev);
        (void)hipDeviceGetAttribute(&cus, hipDeviceAttributeMultiprocessorCount, dev);
        (void)hipFuncSetAttribute((const void*)fwd_megakernel, hipFuncAttributeMaxDynamicSharedMemorySize, LDS_BYTES);
        (void)hipOccupancyMaxActiveBlocksPerMultiprocessor(&per_cu, (const void*)fwd_megakernel, NTHREADS, LDS_BYTES);
        if (per_cu < 1) { fprintf(stderr, "occupancy query says %d blocks/CU; using 1\n", per_cu); per_cu = 1; }
        (void)hipGetLastError();
        grid_blocks = cus * per_cu;
    }
    Params p{};
    p.xp = (const float*)d_in[0]; p.xs = (const float*)d_in[1]; p.cache = (const float*)d_in[2]; p.norm_g = (const float*)d_in[3]; p.w_in = (const float*)d_in[4];
    p.w_pool = (const float*)d_in[5]; p.pool_scale = (const float*)d_in[6]; p.ln_g = (const float*)d_in[7]; p.ln_b = (const float*)d_in[8]; p.w_s = (const float*)d_in[9];
    p.b_s = (const float*)d_in[10]; p.w_a = (const float*)d_in[11]; p.w_b = (const float*)d_in[12]; p.w_o = (const float*)d_in[13]; p.final_g = (const float*)d_in[14];
    p.out = (float*)d_out; p.ws = (unsigned char*)d_ws;
    (void)hipMemsetAsync((char*)d_ws + WS_BAR, 0, WS_BAR_BYTES, stream);
    void* args[] = {&p};
    hipError_t e = hipLaunchCooperativeKernel((const void*)fwd_megakernel, dim3(grid_blocks), dim3(NTHREADS), args, LDS_BYTES, stream);
    if (e != hipSuccess) fprintf(stderr, "cooperative launch failed: %s (grid %d)\n", hipGetErrorString(e), grid_blocks);
}
```

```cpp
#include <hip/hip_runtime.h>
#include <hip/hip_cooperative_groups.h>
#include <cstdio>
#include <cstdint>
namespace cg = cooperative_groups;

#define LAS __attribute__((address_space(3)))
typedef unsigned short bf16_t;
typedef short bf16x8 __attribute__((ext_vector_type(8)));
typedef float f32x4 __attribute__((ext_vector_type(4)));
typedef unsigned u32x4 __attribute__((ext_vector_type(4)));

constexpr int DM = 1024, NP = 4 * 8192, NS = 32 * 64, MTOK = NP + NS, DIN = 4608, SEQ = 8192;
constexpr int C_A = 0, C_GA = 512, C_U = 1024, C_V = 1536, C_GB = 2048, C_RA = 2560, C_RB = 3584;
constexpr float EPS = 1e-6f;
constexpr size_t OUT_YS = (size_t)NP * DM, OUT_SPP = (size_t)MTOK * DM, OUT_SPS = OUT_SPP + 4 * 15 * 512, OUT_SV = OUT_SPS + 32 * 15 * 512;
constexpr size_t MiB = 1u << 20;
constexpr size_t WS_VSTAT = 0, WS_SS = 512 * 1024, WS_BAR = 768 * 1024, WS_BAR_BYTES = 16384, WS_WIN = 1 * MiB, WS_WAB = 10 * MiB, WS_WO = 12 * MiB, WS_WPOOL = 14 * MiB, WS_WSB = 14 * MiB + 131072;
constexpr size_t WS_H = 16 * MiB, WS_T = 84 * MiB, WS_PROJ = 152 * MiB;
constexpr int NWAVES = 8, NTHREADS = 512;
constexpr int LDS_BYTES = 155648;

__device__ __forceinline__ unsigned cvt_pk_bf16(float lo, float hi) { unsigned r; asm volatile("v_cvt_pk_bf16_f32 %0, %1, %2" : "=v"(r) : "v"(lo), "v"(hi)); return r; }
__device__ __forceinline__ float bf_lo(unsigned w) { return __uint_as_float(w << 16); }
__device__ __forceinline__ float bf_hi(unsigned w) { return __uint_as_float(w & 0xffff0000u); }
__device__ __forceinline__ float sigmoidf_fast(float x) { return __builtin_amdgcn_rcpf(1.f + __builtin_amdgcn_exp2f(-1.44269504f * x)); }
__device__ __forceinline__ u32x4 pack8(const f32x4 a, const f32x4 b) { u32x4 w; w.x = cvt_pk_bf16(a[0], a[1]); w.y = cvt_pk_bf16(a[2], a[3]); w.z = cvt_pk_bf16(b[0], b[1]); w.w = cvt_pk_bf16(b[2], b[3]); return w; }
__device__ __forceinline__ void unpack8(const u32x4 w, f32x4& a, f32x4& b) { a = (f32x4){bf_lo(w.x), bf_hi(w.x), bf_lo(w.y), bf_hi(w.y)}; b = (f32x4){bf_lo(w.z), bf_hi(w.z), bf_lo(w.w), bf_hi(w.w)}; }

namespace pg8 {
constexpr int BM = 256, BK = 64, HALF = 128, HTB = HALF * BK * 2, STAGE_BYTES = 8 * HTB, NXCD = 8, WGM = 8;
__host__ __device__ __forceinline__ int lds_byte(int r, int c) { const int st = (r >> 4) * 2 + (c >> 5), rr = r & 15, cc = c & 31, ob = rr * 64 + cc * 2; return st * 1024 + (ob ^ (((ob >> 9) & 1) << 5)); }
__host__ __device__ __forceinline__ void stage_rc(int b, int& R, int& C) { const int st = b / 1024, sb = b % 1024, swz = sb ^ (((sb >> 9) & 1) << 5); R = (st >> 1) * 16 + swz / 64; C = (st & 1) * 32 + (swz % 64) / 2; }
__host__ __device__ __forceinline__ int perm32(int rho) { const int n = rho >> 4, i = rho & 15; return 8 * (i >> 2) + 4 * n + (i & 3); }

struct Unit { int pm, pn, kh; };
struct Gemm { const bf16_t* A; const bf16_t* Bt; int lda, ldb, nt, khA, khB; };

struct Order {
    int nM, nN, nwg, G, c, nkh;
    __device__ void init(int M, int N, int G_, int c_, int nkh_) { nM = M / BM; nN = N / BM; nwg = nM * nN; G = G_; c = c_; nkh = nkh_; }
    __device__ bool next(int i, Unit& u) const {
        const int ti = (nkh == 2) ? (i >> 1) : i; u.kh = (nkh == 2) ? (i & 1) : 0;
        const long L = (long)ti * G + c; if (L >= nwg) return false;
        int wgid = (int)L; { const int q = nwg / NXCD, r = nwg % NXCD, xcd = wgid % NXCD, off = wgid / NXCD; wgid = (xcd < r ? xcd * (q + 1) : r * (q + 1) + (xcd - r) * q) + off; }
        const int nig = WGM * nN, gid = wgid / nig, fm = gid * WGM, gsz = (nM - fm) < WGM ? (nM - fm) : WGM;
        u.pm = fm + ((wgid % nig) % gsz); u.pn = (wgid % nig) / gsz; return true;
    }
};

template <class Epi, class Sched>
__device__ __forceinline__ void gemm_phase(LAS unsigned char* lds, const Gemm g, const Sched& S, const Epi& E, const unsigned delay_ticks) {
    if (delay_ticks) {
        const unsigned long long t0 = __builtin_amdgcn_s_memrealtime();
        while (__builtin_amdgcn_s_memrealtime() - t0 < (unsigned long long)delay_ticks) __builtin_amdgcn_s_sleep(32);
    }
    const int tid = threadIdx.x, wid = __builtin_amdgcn_readfirstlane(tid >> 6), lane = tid & 63, wr = wid >> 2, wc = wid & 3, fr = lane & 15, fq = lane >> 4;
    const int nt = g.nt;
    unsigned voffA[2], voffB[2];
#pragma unroll
    for (int i = 0; i < 2; ++i) { int R, C; stage_rc(tid * 16 + i * 8192, R, C); const int Rb = (R & ~31) + perm32(R & 31);
        voffA[i] = (unsigned)(R * g.lda + C) * 2u; voffB[i] = (unsigned)(Rb * g.ldb + C) * 2u; }
    const size_t kstep = (size_t)(BK * 2);
    const size_t hstepA = (size_t)HALF * g.lda * 2, hstepB = (size_t)HALF * g.ldb * 2;
    const size_t tstepA = 2 * hstepA, tstepB = 2 * hstepB;
    const unsigned ldsw = (unsigned)wid * 1024u;
    const int aoff = lds_byte(wr * 64 + fr, fq * 8), boff = lds_byte(wc * 32 + fr, fq * 8);
#define PG8_SA(b, h) (((b) * 2 + (h)) * HTB)
#define PG8_SB(b, h) ((4 + (b) * 2 + (h)) * HTB)
#define PG8_STAGE(bufoff, gbase, voff) do { _Pragma("unroll") for (int _i = 0; _i < 2; ++_i) \
        __builtin_amdgcn_global_load_lds((const unsigned*)((const char*)(gbase) + (voff)[_i]), (LAS unsigned*)(lds + (bufoff) + ldsw + _i * 8192), 16, 0, 0); } while (0)
#define PG8_LDA(dst, b, h) do { _Pragma("unroll") for (int m = 0; m < 4; ++m) _Pragma("unroll") for (int k = 0; k < 2; ++k) dst[m][k] = *(const LAS bf16x8*)(lds + PG8_SA(b, h) + aoff + m * 2048 + k * 1024); } while (0)
#define PG8_LDB(dst, b, h) do { _Pragma("unroll") for (int n = 0; n < 2; ++n) _Pragma("unroll") for (int k = 0; k < 2; ++k) dst[n][k] = *(const LAS bf16x8*)(lds + PG8_SB(b, h) + boff + n * 2048 + k * 1024); } while (0)
#define PG8_MMA(ai, bj, At, Bt) do { __builtin_amdgcn_s_setprio(1); _Pragma("unroll") for (int m = 0; m < 4; ++m) _Pragma("unroll") for (int n = 0; n < 2; ++n) _Pragma("unroll") for (int k = 0; k < 2; ++k) \
        acc[ai][bj][m][n] = __builtin_amdgcn_mfma_f32_16x16x32_bf16(Bt[n][k], At[m][k], acc[ai][bj][m][n], 0, 0, 0); __builtin_amdgcn_s_setprio(0); } while (0)
#define PG8_WAIT_V(n) asm volatile("s_waitcnt vmcnt(" #n ")" ::: "memory")
#define PG8_WAIT_L(n) asm volatile("s_waitcnt lgkmcnt(" #n ")" ::: "memory")
#define PG8_BAR __builtin_amdgcn_s_barrier()
#define PG8_SCHED __builtin_amdgcn_sched_barrier(0)
#define PG8_ZERO() do { _Pragma("unroll") for (int a = 0; a < 2; ++a) _Pragma("unroll") for (int b = 0; b < 2; ++b) _Pragma("unroll") for (int m = 0; m < 4; ++m) _Pragma("unroll") for (int n = 0; n < 2; ++n) acc[a][b][m][n] = (f32x4){0.f, 0.f, 0.f, 0.f}; } while (0)
    Unit cur, nxt; int ui = 0;
    if (!S.next(0, cur)) return;
    f32x4 acc[2][2][4][2];
    PG8_ZERO();
    bf16x8 At[4][2], B0[2][2], B1[2][2];
    const char* cA = (const char*)g.A + (size_t)cur.pm * tstepA + (size_t)cur.kh * g.khA; const char* cB = (const char*)g.Bt + (size_t)cur.pn * tstepB + (size_t)cur.kh * g.khB;
    PG8_STAGE(PG8_SB(0, 0), cB, voffB); PG8_STAGE(PG8_SB(0, 1), cB + hstepB, voffB); PG8_STAGE(PG8_SA(0, 0), cA, voffA); PG8_STAGE(PG8_SA(0, 1), cA + hstepA, voffA);
    if (wr == 1) PG8_BAR;
    PG8_WAIT_V(2); PG8_BAR;
    PG8_STAGE(PG8_SB(1, 0), cB + kstep, voffB); PG8_STAGE(PG8_SA(1, 0), cA + kstep, voffA); PG8_STAGE(PG8_SB(1, 1), cB + hstepB + kstep, voffB);
    PG8_WAIT_V(6); PG8_BAR;
    for (;;) {
        const bool has_next = S.next(ui + 1, nxt);
        const char* nA = has_next ? (const char*)g.A + (size_t)nxt.pm * tstepA + (size_t)nxt.kh * g.khA : cA; const char* nB = has_next ? (const char*)g.Bt + (size_t)nxt.pn * tstepB + (size_t)nxt.kh * g.khB : cB;
        for (int t = 0; t < nt; t += 2) {
            const bool last = (t == nt - 2);
            const char* a1 = cA + (size_t)(t + 1) * kstep;
            const char* a2 = last ? nA : cA + (size_t)(t + 2) * kstep; const char* b2 = last ? nB : cB + (size_t)(t + 2) * kstep;
            const char* a3 = a2 + kstep; const char* b3 = b2 + kstep;
            PG8_LDB(B0, 0, 0); PG8_LDB(B1, 0, 1); PG8_SCHED; PG8_LDA(At, 0, 0); PG8_STAGE(PG8_SA(1, 1), a1 + hstepA, voffA);
            PG8_WAIT_V(8); PG8_WAIT_L(0); PG8_BAR; PG8_MMA(0, 0, At, B0); PG8_MMA(0, 1, At, B1); PG8_BAR; PG8_SCHED;
            PG8_LDA(At, 0, 1); PG8_STAGE(PG8_SB(0, 0), b2, voffB); PG8_STAGE(PG8_SB(0, 1), b2 + hstepB, voffB); PG8_STAGE(PG8_SA(0, 0), a2, voffA);
            PG8_WAIT_V(8); PG8_WAIT_L(0); PG8_BAR; PG8_MMA(1, 0, At, B0); PG8_MMA(1, 1, At, B1); PG8_BAR; PG8_SCHED;
            PG8_LDB(B0, 1, 0); PG8_LDB(B1, 1, 1); PG8_SCHED; PG8_LDA(At, 1, 0); PG8_STAGE(PG8_SA(0, 1), a2 + hstepA, voffA);
            PG8_WAIT_V(8); PG8_WAIT_L(0); PG8_BAR; PG8_MMA(0, 0, At, B0); PG8_MMA(0, 1, At, B1); PG8_BAR; PG8_SCHED;
            PG8_LDA(At, 1, 1); PG8_STAGE(PG8_SB(1, 0), b3, voffB); PG8_STAGE(PG8_SB(1, 1), b3 + hstepB, voffB); PG8_STAGE(PG8_SA(1, 0), a3, voffA);
            PG8_WAIT_V(8); PG8_WAIT_L(0); PG8_BAR; PG8_MMA(1, 0, At, B0); PG8_MMA(1, 1, At, B1); PG8_BAR; PG8_SCHED;
        }
        if (wr == 0) PG8_BAR;
        E(acc, cur, wr, wc, fr, fq);
        if (!has_next) break;
        if (!Epi::keep(cur)) PG8_ZERO();
        cur = nxt; cA = nA; cB = nB; ++ui;
        if (wr == 1) PG8_BAR;
    }
    PG8_WAIT_V(0);
    PG8_BAR;
#undef PG8_SA
#undef PG8_SB
#undef PG8_STAGE
#undef PG8_LDA
#undef PG8_LDB
#undef PG8_MMA
#undef PG8_WAIT_V
#undef PG8_WAIT_L
#undef PG8_BAR
#undef PG8_SCHED
#undef PG8_ZERO
}
}
using pg8::Unit;

struct EpiProj {
    bf16_t* proj; float* vstat;
    static __device__ __forceinline__ bool keep(const Unit&) { return false; }
    __device__ __forceinline__ void operator()(f32x4 (&acc)[2][2][4][2], const Unit& u, int wr, int wc, int fr, int fq) const {
        const int row0 = u.pm * 256 + wr * 64 + fr, col0 = u.pn * 256 + wc * 32 + 8 * fq;
        const int pn = u.pn;
        const int kind = (pn >= 10) ? 2 : ((pn == 2 || pn == 3 || pn == 8 || pn == 9) ? 1 : ((pn == 6 || pn == 7) ? 3 : 0));
#pragma unroll
        for (int ai = 0; ai < 2; ++ai)
#pragma unroll
            for (int m = 0; m < 4; ++m) {
                const int row = row0 + ai * 128 + m * 16;
                bf16_t* rowp = proj + (size_t)row * DIN + col0;
                float s1 = 0.f, s2 = 0.f;
                if (kind == 2) {
#pragma unroll
                    for (int n = 0; n < 2; ++n)
#pragma unroll
                        for (int e = 0; e < 4; ++e) {
                            const float ea = __builtin_amdgcn_exp2f(-1.44269504f * acc[ai][0][m][n][e]), eb = __builtin_amdgcn_exp2f(-1.44269504f * acc[ai][1][m][n][e]);
                            acc[ai][0][m][n][e] = (1.f + eb) * __builtin_amdgcn_rcpf(1.f + ea); acc[ai][1][m][n][e] = __builtin_amdgcn_rcpf(1.f + eb);
                        }
                }
#pragma unroll
                for (int bj = 0; bj < 2; ++bj) {
                    f32x4 v0 = acc[ai][bj][m][0], v1 = acc[ai][bj][m][1];
                    if (kind == 1) {
#pragma unroll
                        for (int e = 0; e < 4; ++e) { v0[e] = v0[e] * sigmoidf_fast(v0[e]); v1[e] = v1[e] * sigmoidf_fast(v1[e]); }
                    } else if (kind == 3) {
#pragma unroll
                        for (int e = 0; e < 4; ++e) { s1 += v0[e] + v1[e]; s2 += v0[e] * v0[e] + v1[e] * v1[e]; }
                    }
                    *(u32x4*)(rowp + bj * 128) = pack8(v0, v1);
                }
                if (kind == 3) {
                    s1 += __shfl_xor(s1, 16); s1 += __shfl_xor(s1, 32); s2 += __shfl_xor(s2, 16); s2 += __shfl_xor(s2, 32);
                    if (fq == 0) { atomicAdd(vstat + 2 * row, s1); atomicAdd(vstat + 2 * row + 1, s2); }
                }
            }
    }
};
struct EpiMerge {
    const bf16_t* proj; bf16_t* outm;
    static __device__ __forceinline__ bool keep(const Unit& u) { return u.kh == 0; }
    __device__ __forceinline__ void operator()(f32x4 (&acc)[2][2][4][2], const Unit& u, int wr, int wc, int fr, int fq) const {
        const int row0 = u.pm * 256 + wr * 64 + fr, col0 = u.pn * 256 + wc * 32 + 8 * fq;
        const int gcol = C_RA + 512 * u.pn + wc * 32 + 8 * fq + (u.kh == 0 ? 0 : 128);
#pragma unroll
        for (int ai = 0; ai < 2; ++ai) {
            u32x4 gt[4][2];
#pragma unroll
            for (int m = 0; m < 4; ++m)
#pragma unroll
                for (int bj = 0; bj < 2; ++bj)
                    gt[m][bj] = *(const u32x4*)(proj + (size_t)(row0 + ai * 128 + m * 16) * DIN + gcol + 256 * bj);
            __builtin_amdgcn_sched_barrier(0);
            if (u.kh == 0) {
#pragma unroll
                for (int m = 0; m < 4; ++m)
#pragma unroll
                    for (int bj = 0; bj < 2; ++bj) { f32x4 r0, r1; unpack8(gt[m][bj], r0, r1); acc[ai][bj][m][0] *= r0; acc[ai][bj][m][1] *= r1; }
            } else {
#pragma unroll
                for (int m = 0; m < 4; ++m)
#pragma unroll
                    for (int bj = 0; bj < 2; ++bj) {
                        const int row = row0 + ai * 128 + m * 16, c = col0 + bj * 128;
                        f32x4 b0, b1; unpack8(gt[m][bj], b0, b1);
                        *(u32x4*)(outm + (size_t)row * DM + c) = pack8(acc[ai][bj][m][0] * b0, acc[ai][bj][m][1] * b1);
                    }
            }
            __builtin_amdgcn_sched_barrier(0);
        }
    }
};
struct EpiOut {
    const float* xp; const float* xs; float* out; float* ss;
    static __device__ __forceinline__ bool keep(const Unit&) { return false; }
    __device__ __forceinline__ void operator()(f32x4 (&acc)[2][2][4][2], const Unit& u, int wr, int wc, int fr, int fq) const {
        const int row0 = u.pm * 256 + wr * 64 + fr, col0 = u.pn * 256 + wc * 32 + 8 * fq;
        const float* xbase = (u.pm * 256 < NP) ? xp : xs - (size_t)NP * DM;
#pragma unroll
        for (int ai = 0; ai < 2; ++ai) {
            f32x4 xv[4][2][2];
#pragma unroll
            for (int m = 0; m < 4; ++m)
#pragma unroll
                for (int bj = 0; bj < 2; ++bj) {
                    const float* xr = xbase + (size_t)(row0 + ai * 128 + m * 16) * DM + col0 + bj * 128;
                    xv[m][bj][0] = *(const f32x4*)xr; xv[m][bj][1] = *(const f32x4*)(xr + 4);
                }
            __builtin_amdgcn_sched_barrier(0);
#pragma unroll
            for (int m = 0; m < 4; ++m) {
                const int row = row0 + ai * 128 + m * 16;
                float* orow = out + (size_t)row * DM;
                float q = 0.f;
#pragma unroll
                for (int bj = 0; bj < 2; ++bj) {
                    const int c = col0 + bj * 128;
                    const f32x4 o0 = xv[m][bj][0] + acc[ai][bj][m][0], o1 = xv[m][bj][1] + acc[ai][bj][m][1];
                    *(f32x4*)(orow + c) = o0; *(f32x4*)(orow + c + 4) = o1;
                    q += (o0[0] * o0[0] + o0[1] * o0[1]) + (o0[2] * o0[2] + o0[3] * o0[3]) + (o1[0] * o1[0] + o1[1] * o1[1]) + (o1[2] * o1[2] + o1[3] * o1[3]);
                }
                q += __shfl_xor(q, 16); q += __shfl_xor(q, 32);
                if (fq == 0) atomicAdd(ss + row, q);
            }
            __builtin_amdgcn_sched_barrier(0);
        }
    }
};

struct Params {
    const float *xp, *xs, *cache, *norm_g, *w_in, *w_pool, *pool_scale, *ln_g, *ln_b, *w_s, *b_s, *w_a, *w_b, *w_o, *final_g;
    float* out; unsigned char* ws;
};
struct Frame {
    LAS unsigned char* lds; int tid, lane, wave, vcu, G;
    bf16_t *Win_t, *Wab_t, *Wo_t, *Wpool_t, *Ws_b, *H, *T, *PROJ;
    float *vstat, *ss;
};
#define LDS_WAIT() asm volatile("s_waitcnt lgkmcnt(0)" ::: "memory")
__device__ __forceinline__ float wave_sum(float v) {
#pragma unroll
    for (int o = 1; o < 64; o <<= 1) v += __shfl_xor(v, o);
    return v;
}
__device__ __forceinline__ void transpose_item(const float* W, int N, bf16_t* WT, int ldt, LAS float* scr, int item, int nblk, int lane, int perm) {
    const int kb = item / nblk, nb = item % nblk, k0 = 64 * kb, n0 = 32 * nb;
    int nd = n0;
    if (perm && n0 >= C_RA) { const int isb = n0 >= C_RB ? 1 : 0, rel = n0 - (isb ? C_RB : C_RA), k = rel >> 7; nd = C_RA + 256 * k + 128 * isb + (rel & 127); }
#pragma unroll 8
    for (int i = 0; i < 32; ++i) { const int kk = 2 * i + (lane >> 5); scr[kk * 33 + (lane & 31)] = W[(size_t)(k0 + kk) * N + n0 + (lane & 31)]; }
    LDS_WAIT(); asm volatile("" ::: "memory");
    const int c = lane & 7;
#pragma unroll
    for (int j = 0; j < 4; ++j) { const int n = (lane >> 3) + 8 * j; const LAS float* s = scr + (8 * c) * 33 + n;
        u32x4 o; o.x = cvt_pk_bf16(s[0 * 33], s[1 * 33]); o.y = cvt_pk_bf16(s[2 * 33], s[3 * 33]); o.z = cvt_pk_bf16(s[4 * 33], s[5 * 33]); o.w = cvt_pk_bf16(s[6 * 33], s[7 * 33]);
        *(u32x4*)(WT + (size_t)(nd + n) * ldt + k0 + 8 * c) = o; }
    LDS_WAIT(); asm volatile("" ::: "memory");
}

__device__ __forceinline__ void p0_prologue(const Params& P, Frame& F) {
    LAS float* scr = (LAS float*)(F.lds + F.wave * 16384);
    const int gw = F.vcu * NWAVES + F.wave, NGW = F.G * NWAVES, lane = F.lane;
    constexpr int I_IN = 16 * 144, I_A = 8 * 32, I_O = 16 * 32, I_P = 2 * 4;
    constexpr int NITEMS = I_IN + 2 * I_A + I_O + 4 * I_P;
    for (int it = gw; it < NITEMS; it += NGW) {
        int r = it;
        if (r < I_IN) { transpose_item(P.w_in, DIN, F.Win_t, 1024, scr, r, 144, lane, 1); continue; } r -= I_IN;
        if (r < I_A) { transpose_item(P.w_a, 1024, F.Wab_t, 1024, scr, r, 32, lane, 0); continue; } r -= I_A;
        if (r < I_A) { transpose_item(P.w_b, 1024, F.Wab_t + 512, 1024, scr, r, 32, lane, 0); continue; } r -= I_A;
        if (r < I_O) { transpose_item(P.w_o, 1024, F.Wo_t, 1024, scr, r, 32, lane, 0); continue; } r -= I_O;
        { const int g = r / I_P; transpose_item(P.w_pool + g * 16384, 128, F.Wpool_t + g * 16384, 128, scr, r % I_P, 4, lane, 0); }
    }
    const int gt = F.vcu * NTHREADS + F.tid, NGT = F.G * NTHREADS;
    for (int e = gt; e < 4 * 128 * 128 / 2; e += NGT) { const int i = (e >> 6) & 127, j = (e & 63) * 2; const float lo = P.w_s[2 * e], hi = P.w_s[2 * e + 1]; const bool z = (i < 64 && j >= 64);
        ((unsigned*)F.Ws_b)[e] = z ? 0u : cvt_pk_bf16(lo, hi); }
    for (int e = gt; e < MTOK * 2; e += NGT) F.vstat[e] = 0.f;
    for (int e = gt; e < MTOK; e += NGT) F.ss[e] = 0.f;
    f32x4 gv[4];
#pragma unroll
    for (int j = 0; j < 4; ++j) gv[j] = *((const f32x4*)P.norm_g + lane + 64 * j);
    for (int m0 = gw; m0 < MTOK; m0 += 4 * NGW) {
        f32x4 v[4][4];
#pragma unroll
        for (int q = 0; q < 4; ++q) { const int m = m0 + q * NGW; if (m < MTOK) {
            const float* xrow = (m < NP) ? P.xp + (size_t)m * DM : P.xs + (size_t)(m - NP) * DM;
#pragma unroll
            for (int j = 0; j < 4; ++j) v[q][j] = ((const f32x4*)xrow)[lane + 64 * j]; } }
#pragma unroll
        for (int q = 0; q < 4; ++q) { const int m = m0 + q * NGW; if (m < MTOK) {
            float s = 0.f;
#pragma unroll
            for (int j = 0; j < 4; ++j) s += (v[q][j].x * v[q][j].x + v[q][j].y * v[q][j].y) + (v[q][j].z * v[q][j].z + v[q][j].w * v[q][j].w);
            const float r = 1.f / sqrtf(wave_sum(s) * (1.f / DM) + EPS);
            unsigned long long* o8 = (unsigned long long*)(F.H + (size_t)m * DM) + lane;
#pragma unroll
            for (int j = 0; j < 4; ++j) { const f32x4 h = v[q][j] * r * gv[j]; o8[64 * j] = (unsigned long long)cvt_pk_bf16(h.x, h.y) | ((unsigned long long)cvt_pk_bf16(h.z, h.w) << 32); } } }
    }
}

struct PoolRegs { f32x4 lo[5], hi[5]; };
__device__ __forceinline__ void pool_load(const Params& P, const Frame& F, int rt, int g, PoolRegs& R) {
    const int tid = F.tid, lane = F.lane, fr = lane & 15, fq = lane >> 4, wd = F.wave & 3, wt = F.wave >> 2;
    const int R0 = rt * 128; const bool smp = R0 >= NP;
#pragma unroll
    for (int q = 0; q < 5; ++q) {
        const int p = tid + 512 * q, seg = p / 1280, rem = p - seg * 1280, r = rem >> 4, cb = rem & 15, rel = r - 16;
        const int segrow = R0 + 64 * seg;
        f32x4 lo = (f32x4){0.f, 0.f, 0.f, 0.f}, hi = lo;
        if (rel >= 0 || (!smp && (segrow & (SEQ - 1)) != 0)) {
            unpack8(*(const u32x4*)(F.PROJ + (size_t)(segrow + rel) * DIN + C_A + g * 128 + cb * 8), lo, hi);
        } else if (smp && rel >= -15) {
            const int s = (segrow - NP) >> 6; const float* cp = P.cache + ((size_t)s * 15 + (15 + rel)) * 512 + g * 128 + cb * 8;
            lo = *(const f32x4*)cp; hi = *(const f32x4*)(cp + 4);
        }
        R.lo[q] = lo; R.hi[q] = hi;
    }
}
__device__ __forceinline__ void pool_stream(const Params& P, Frame& F, int rt0, int rt_step, int g) {
    const int tid = F.tid, lane = F.lane, fr = lane & 15, fq = lane >> 4, wd = F.wave & 3, wt = F.wave >> 2;
    LAS float* aT = (LAS float*)F.lds;
    LAS bf16_t* PA = (LAS bf16_t*)(F.lds + 81920);
    bf16x8 wA[2][4];
    { const bf16_t* wp = F.Wpool_t + g * 16384;
#pragma unroll
      for (int n = 0; n < 2; ++n) { const int d = 32 * wd + 8 * (fr >> 2) + 4 * n + (fr & 3);
#pragma unroll
        for (int kk = 0; kk < 4; ++kk) wA[n][kk] = *(const bf16x8*)(wp + d * 128 + kk * 32 + fq * 8); } }
    const int d0 = g * 128 + 32 * wd + 8 * fq;
    const f32x4 ps0 = *(const f32x4*)(P.pool_scale + d0), ps1 = *(const f32x4*)(P.pool_scale + d0 + 4);
    constexpr int NRT = MTOK / 128;
    PoolRegs cur; u32x4 gate[4];
    if (rt0 < NRT) { pool_load(P, F, rt0, g, cur);
#pragma unroll
        for (int nb = 0; nb < 4; ++nb) gate[nb] = *(const u32x4*)(F.PROJ + (size_t)(rt0 * 128 + 64 * wt + 16 * nb + fr) * DIN + C_GA + d0); }
    for (int rt = rt0; rt < NRT; rt += rt_step) {
        const int R0 = rt * 128; const bool smp = R0 >= NP;
#pragma unroll
        for (int q = 0; q < 5; ++q) {
            const int p = tid + 512 * q, seg = p / 1280, rem = p - seg * 1280, r = rem >> 4, cb = rem & 15;
            LAS float* dst = aT + (seg * 80 + r) * 128 + cb * 8;
            *(LAS f32x4*)dst = cur.lo[q]; *(LAS f32x4*)(dst + 4) = cur.hi[q];
        }
        __syncthreads();
        if (rt + rt_step < NRT) pool_load(P, F, rt + rt_step, g, cur);
        {
            const int c = tid & 127, q = tid >> 7, seg = q >> 1, k0 = 32 * (q & 1), w = 2 << g;
            const int segrow = R0 + 64 * seg, tpos0 = segrow & (SEQ - 1);
            const LAS float* base = aT + (seg * 80 + 16) * 128 + c;
            float S = 0.f;
            for (int d = 1; d < w; ++d) S += base[(k0 - d) * 128];
            const float invw = 1.f / (float)w;
            for (int k = k0; k < k0 + 32; ++k) {
                const float a = base[k * 128]; S += a;
                float inv = invw;
                if (!smp) { const int t = tpos0 + k; if (t + 1 < w) inv = __builtin_amdgcn_rcpf((float)(t + 1)); }
                const float o = S * inv - a;
                PA[(64 * seg + k) * 136 + c] = (bf16_t)(cvt_pk_bf16(o, 0.f) & 0xffffu);
                S -= base[(k - w + 1) * 128];
                if (!smp) { const int t = tpos0 + k; if (t >= SEQ - 15) P.out[OUT_SPP + ((size_t)(R0 >> 13) * 15 + (t - (SEQ - 15))) * 512 + g * 128 + c] = a; }
                else if (k >= 49) { const int s = (segrow - NP) >> 6; P.out[OUT_SPS + ((size_t)s * 15 + (k - 49)) * 512 + g * 128 + c] = a; }
            }
        }
        __syncthreads();
        f32x4 acc[4][2];
#pragma unroll
        for (int nb = 0; nb < 4; ++nb) { acc[nb][0] = (f32x4){0.f, 0.f, 0.f, 0.f}; acc[nb][1] = acc[nb][0]; }
#pragma unroll
        for (int nb = 0; nb < 4; ++nb) {
            const LAS bf16_t* pr = PA + (64 * wt + 16 * nb + fr) * 136 + fq * 8;
#pragma unroll
            for (int kk = 0; kk < 4; ++kk) {
                const bf16x8 b = *(const LAS bf16x8*)(pr + kk * 32);
                acc[nb][0] = __builtin_amdgcn_mfma_f32_16x16x32_bf16(wA[0][kk], b, acc[nb][0], 0, 0, 0);
                acc[nb][1] = __builtin_amdgcn_mfma_f32_16x16x32_bf16(wA[1][kk], b, acc[nb][1], 0, 0, 0);
            }
        }
#pragma unroll
        for (int nb = 0; nb < 4; ++nb) {
            const int row = R0 + 64 * wt + 16 * nb + fr;
            f32x4 s0, s1; unpack8(gate[nb], s0, s1);
            *(u32x4*)(F.T + (size_t)row * DM + d0) = pack8(acc[nb][0] * ps0 * s0, acc[nb][1] * ps1 * s1);
        }
        if (rt + rt_step < NRT) {
#pragma unroll
            for (int nb = 0; nb < 4; ++nb) gate[nb] = *(const u32x4*)(F.PROJ + (size_t)((rt + rt_step) * 128 + 64 * wt + 16 * nb + fr) * DIN + C_GA + d0); }
    }
}
struct SguRegs { u32x4 v[4]; float s1[4], s2[4]; };
struct SguGates { u32x4 gu[4], gg[4]; float bs[4]; };
__device__ __forceinline__ void sgu_load(const Params& P, const Frame& F, int rt, int g, SguRegs& R) {
    const int tid = F.tid, lane = F.lane, fr = lane & 15, fq = lane >> 4, wcg = F.wave & 3, wt = F.wave >> 2;
    const int R0 = rt * 128, cb = tid & 15;
#pragma unroll
    for (int q = 0; q < 4; ++q) { const int row = R0 + (tid >> 4) + 32 * q;
        R.v[q] = *(const u32x4*)(F.PROJ + (size_t)row * DIN + C_V + g * 128 + cb * 8); R.s1[q] = F.vstat[2 * row]; R.s2[q] = F.vstat[2 * row + 1]; }
}
__device__ __forceinline__ void sgu_load_gates(const Params& P, const Frame& F, int rt, int g, SguGates& R) {
    const int lane = F.lane, fr = lane & 15, fq = lane >> 4, wcg = F.wave & 3, wt = F.wave >> 2;
    const int R0 = rt * 128; const bool smp = R0 >= NP;
    const int c0 = g * 128 + 32 * wcg + 8 * fq;
#pragma unroll
    for (int nb = 0; nb < 4; ++nb) { const int i = 64 * wt + 16 * nb + fr; const bf16_t* pr = F.PROJ + (size_t)(R0 + i) * DIN;
        R.gu[nb] = *(const u32x4*)(pr + C_U + c0); R.gg[nb] = *(const u32x4*)(pr + C_GB + c0); R.bs[nb] = P.b_s[g * 128 + (smp ? (i & 63) : i)]; }
}
__device__ __forceinline__ void sgu_stream(const Params& P, Frame& F, int rt0, int rt_step, int g) {
    const int tid = F.tid, lane = F.lane, fr = lane & 15, fq = lane >> 4, wcg = F.wave & 3, wt = F.wave >> 2;
    LAS bf16_t* VH = (LAS bf16_t*)(F.lds + 116736);
    const bf16_t* wp = F.Ws_b + g * 16384;
    bf16x8 wB[4][4];
#pragma unroll
    for (int nb = 0; nb < 4; ++nb) { const int i = 64 * wt + 16 * nb + fr;
#pragma unroll
        for (int kk = 0; kk < 4; ++kk) wB[nb][kk] = (kk < 2 || wt == 1) ? *(const bf16x8*)(wp + i * 128 + kk * 32 + fq * 8) : (bf16x8){0, 0, 0, 0, 0, 0, 0, 0}; }
    const int cb = tid & 15, c0 = g * 128 + 32 * wcg + 8 * fq;
    const f32x4 lg0 = *(const f32x4*)(P.ln_g + g * 128 + cb * 8), lg1 = *(const f32x4*)(P.ln_g + g * 128 + cb * 8 + 4);
    const f32x4 lb0 = *(const f32x4*)(P.ln_b + g * 128 + cb * 8), lb1 = *(const f32x4*)(P.ln_b + g * 128 + cb * 8 + 4);
    constexpr int NRT = MTOK / 128;
    SguRegs cur; SguGates gt; if (rt0 < NRT) { sgu_load(P, F, rt0, g, cur); sgu_load_gates(P, F, rt0, g, gt); }
    bool w_is_smp = false;
    for (int rt = rt0; rt < NRT; rt += rt_step) {
        const int R0 = rt * 128; const bool smp = R0 >= NP;
        if (smp && !w_is_smp) {
            w_is_smp = true;
#pragma unroll
            for (int nb = 0; nb < 4; ++nb) { const int i = 16 * nb + fr;
#pragma unroll
                for (int kk = 0; kk < 4; ++kk) wB[nb][kk] = ((kk < 2) == (wt == 0)) ? *(const bf16x8*)(wp + i * 128 + (kk & 1) * 32 + fq * 8) : (bf16x8){0, 0, 0, 0, 0, 0, 0, 0}; }
        }
#pragma unroll
        for (int q = 0; q < 4; ++q) {
            const int j = (tid >> 4) + 32 * q, row = R0 + j;
            f32x4 v0, v1; unpack8(cur.v[q], v0, v1);
            const float mean = cur.s1[q] * (1.f / 512.f), var = fmaxf(cur.s2[q] * (1.f / 512.f) - mean * mean, 0.f), rstd = 1.f / sqrtf(var + EPS);
            v0 = (v0 - mean) * rstd * lg0 + lb0; v1 = (v1 - mean) * rstd * lg1 + lb1;
            if (smp) { float* o = P.out + OUT_SV + (size_t)(row - NP) * 512 + g * 128 + cb * 8; *(f32x4*)o = v0; *(f32x4*)(o + 4) = v1; }
            *(LAS u32x4*)(VH + j * 136 + cb * 8) = pack8(v0, v1);
        }
        __syncthreads();
        if (rt + rt_step < NRT) sgu_load(P, F, rt + rt_step, g, cur);
        f32x4 acc[4][2];
#pragma unroll
        for (int nb = 0; nb < 4; ++nb) { acc[nb][0] = (f32x4){0.f, 0.f, 0.f, 0.f}; acc[nb][1] = acc[nb][0]; }
#pragma unroll
        for (int kk = 0; kk < 4; ++kk) {
            const bool need = (kk < 2) ? (wt == 0 || !smp) : (wt == 1);
            if (need) {
                bf16x8 a[2];
#pragma unroll
                for (int n = 0; n < 2; ++n) { const int c = 32 * wcg + 8 * (fr >> 2) + 4 * n + (fr & 3); const LAS bf16_t* vp = VH + (kk * 32 + fq * 8) * 136 + c;
#pragma unroll
                    for (int e = 0; e < 8; ++e) a[n][e] = (short)vp[e * 136]; }
#pragma unroll
                for (int nb = 0; nb < 4; ++nb) {
                    acc[nb][0] = __builtin_amdgcn_mfma_f32_16x16x32_bf16(a[0], wB[nb][kk], acc[nb][0], 0, 0, 0);
                    acc[nb][1] = __builtin_amdgcn_mfma_f32_16x16x32_bf16(a[1], wB[nb][kk], acc[nb][1], 0, 0, 0);
                }
            }
        }
#pragma unroll
        for (int nb = 0; nb < 4; ++nb) {
            const int i = 64 * wt + 16 * nb + fr, row = R0 + i;
            const float bs = gt.bs[nb];
            f32x4 u0, u1, g0, g1; unpack8(gt.gu[nb], u0, u1); unpack8(gt.gg[nb], g0, g1);
            *(u32x4*)(F.T + (size_t)row * DM + 512 + c0) = pack8((acc[nb][0] + bs) * u0 * g0, (acc[nb][1] + bs) * u1 * g1);
        }
        if (rt + rt_step < NRT) sgu_load_gates(P, F, rt + rt_step, g, gt);
        __syncthreads();
    }
}

#define XB_TMO      128
#define XB_XCNT(j)  (256  + 64 * (j))
#define XB_XSUB(j)  (1280 + 64 * (j))
#define XB_XGEN(j)  (2304 + 64 * (j))
#define XB_TOP      3328
#define XB_TOPGEN   3392
#define XCD_BAR_WORDS 3456
#define XB_SPIN_CAP (1u << 18)
__device__ __forceinline__ unsigned xb_ld(unsigned* p)              { return __hip_atomic_load(p, __ATOMIC_RELAXED, __HIP_MEMORY_SCOPE_AGENT); }
__device__ __forceinline__ unsigned xb_add(unsigned* p, unsigned v) { return __hip_atomic_fetch_add(p, v, __ATOMIC_RELAXED, __HIP_MEMORY_SCOPE_AGENT); }
__device__ __forceinline__ unsigned xb_xcc_id() { return (unsigned)__builtin_amdgcn_s_getreg((3 << 11) | 20) & 0xFu; }
#define XB_SPIN(cond, bar) do { unsigned _sp = 0; while (cond) { __builtin_amdgcn_s_sleep(1); \
    if ((++_sp & 255u) == 0u) { if (xb_ld(&(bar)[XB_TMO])) break; if (_sp > XB_SPIN_CAP) { atomicAdd(&(bar)[XB_TMO], 1u); break; } } } } while (0)
struct XcdBarrier { unsigned* bar; unsigned x; volatile LAS unsigned* st; };
__device__ __forceinline__ XcdBarrier xcd_barrier_post(unsigned* bar, volatile LAS unsigned* st) {
    XcdBarrier b; b.bar = bar; b.x = xb_xcc_id(); b.st = st;
    if (threadIdx.x == 0) (void)xb_add(&bar[XB_XCNT(b.x)], 1u);
    return b;
}
__device__ __forceinline__ void xcd_barrier_complete(unsigned* bar, unsigned x, unsigned& nloc, unsigned& nx) {
    const unsigned G = gridDim.x * gridDim.y * gridDim.z;
    unsigned sum, cnt, mine, sp = 0u;
    for (;;) {
        sum = 0u; cnt = 0u; mine = 0u;
#pragma unroll
        for (unsigned j = 0; j < 16; ++j) { const unsigned c = xb_ld(&bar[XB_XCNT(j)]); sum += c; cnt += (c > 0u) ? 1u : 0u; mine = (j == x) ? c : mine; }
        if (sum == G) break;
        __builtin_amdgcn_s_sleep(1);
        if ((++sp & 255u) == 0u) { if (xb_ld(&bar[XB_TMO])) break; if (sp > XB_SPIN_CAP) { atomicAdd(&bar[XB_TMO], 1u); break; } }
    }
    nloc = mine > 0u ? mine : 1u; nx = cnt > 0u ? cnt : 1u;
}
__device__ __forceinline__ void xcd_barrier(const XcdBarrier& b) {
    asm volatile("s_waitcnt vmcnt(0)" ::: "memory");
    __syncthreads();
    if (threadIdx.x == 0) {
        unsigned* bar = b.bar;
        __builtin_amdgcn_s_waitcnt(0);
        unsigned nloc = b.st[0], nx = b.st[1];
        if (nloc == 0u) { xcd_barrier_complete(bar, b.x, nloc, nx); b.st[0] = nloc; b.st[1] = nx; }
        const unsigned old = xb_add(&bar[XB_XSUB(b.x)], 1u);
        const unsigned gen = old / nloc;
        if (old + 1u == (gen + 1u) * nloc) {
            __builtin_amdgcn_fence(__ATOMIC_RELEASE, "agent");
            asm volatile("s_waitcnt vmcnt(0)" ::: "memory");
            const unsigned og = xb_add(&bar[XB_TOP], 1u);
            const unsigned tg = og / nx;
            if (og + 1u == (tg + 1u) * nx) xb_add(&bar[XB_TOPGEN], 1u);
            else XB_SPIN(xb_ld(&bar[XB_TOPGEN]) == tg, bar);
            __builtin_amdgcn_fence(__ATOMIC_ACQUIRE, "agent");
            xb_add(&bar[XB_XGEN(b.x)], 1u);
            asm volatile("s_waitcnt vmcnt(0)" ::: "memory");
        } else {
            XB_SPIN(xb_ld(&bar[XB_XGEN(b.x)]) == gen, bar);
            __builtin_amdgcn_fence(__ATOMIC_ACQUIRE, "agent");
            asm volatile("s_waitcnt vmcnt(0)" ::: "memory");
        }
    }
    __syncthreads();
}

__global__ void __launch_bounds__(NTHREADS, 2) fwd_megakernel(Params P) {
    extern __shared__ __attribute__((aligned(16))) unsigned char lds_raw[];
    cg::grid_group grid = cg::this_grid();
    Frame F;
    F.lds = (LAS unsigned char*)lds_raw;
    F.tid = threadIdx.x; F.lane = F.tid & 63; F.wave = __builtin_amdgcn_readfirstlane(F.tid >> 6);
    F.G = gridDim.x; { const int bx = blockIdx.x; F.vcu = (F.G % 8 == 0) ? (bx % 8) * (F.G / 8) + bx / 8 : bx; }
    unsigned char* ws = P.ws;
    F.vstat = (float*)(ws + WS_VSTAT); F.ss = (float*)(ws + WS_SS);
    F.Win_t = (bf16_t*)(ws + WS_WIN); F.Wab_t = (bf16_t*)(ws + WS_WAB); F.Wo_t = (bf16_t*)(ws + WS_WO); F.Wpool_t = (bf16_t*)(ws + WS_WPOOL); F.Ws_b = (bf16_t*)(ws + WS_WSB);
    F.H = (bf16_t*)(ws + WS_H); F.T = (bf16_t*)(ws + WS_T); F.PROJ = (bf16_t*)(ws + WS_PROJ);

    volatile LAS unsigned* bst = (volatile LAS unsigned*)(F.lds + 151552);
    if (F.tid < 2) bst[F.tid] = 0u;
    __syncthreads();
    const XcdBarrier xbar = xcd_barrier_post((unsigned*)(ws + WS_BAR), bst);
    p0_prologue(P, F);
    grid.sync();
    { pg8::Gemm g{F.H, F.Win_t, 1024, 1024, 16, 0, 0}; pg8::Order S; S.init(MTOK, DIN, F.G, (int)blockIdx.x, 1);
      EpiProj E{F.PROJ, F.vstat};
      const int c = (int)blockIdx.x, grp = ((c >> 3) & 1) + (c >= 144 ? 2 : 0);
      pg8::gemm_phase<EpiProj, pg8::Order>(F.lds, g, S, E, 0u); }
    xcd_barrier(xbar);
    { const int u0 = (int)blockIdx.x, Gp = F.G & ~7;
      if (u0 < Gp) { const int g = (u0 >> 1) & 3; if (u0 & 1) sgu_stream(P, F, u0 >> 3, Gp >> 3, g); else pool_stream(P, F, u0 >> 3, Gp >> 3, g); } }
    xcd_barrier(xbar);
    { pg8::Gemm g{F.T, F.Wab_t, 1024, 1024, 8, 1024, 1024}; pg8::Order S; S.init(MTOK, DM, F.G, (int)blockIdx.x, 2);
      EpiMerge E{F.PROJ, F.H};
      const int c = (int)blockIdx.x, grp = (c < 32) ? 0 : 1 + ((c >> 3) & 3);
      pg8::gemm_phase<EpiMerge, pg8::Order>(F.lds, g, S, E, 0u); }
    xcd_barrier(xbar);
    { pg8::Gemm g{F.H, F.Wo_t, 1024, 1024, 16, 0, 0}; pg8::Order S; S.init(MTOK, DM, F.G, (int)blockIdx.x, 1);
      EpiOut E{P.xp, P.xs, P.out, F.ss};
      const int c = (int)blockIdx.x, grp = (c < 32) ? 0 : 1 + ((c >> 3) & 3);
      pg8::gemm_phase<EpiOut, pg8::Order>(F.lds, g, S, E, 0u); }
    xcd_barrier(xbar);
    { const int gw = F.vcu * NWAVES + F.wave, NGW = F.G * NWAVES, lane = F.lane;
      f32x4 gv[4];
#pragma unroll
      for (int j = 0; j < 4; ++j) gv[j] = *((const f32x4*)P.final_g + lane + 64 * j);
      for (int m0 = gw; m0 < MTOK; m0 += 4 * NGW) {
          f32x4 v[4][4]; float r[4];
#pragma unroll
          for (int q = 0; q < 4; ++q) { const int m = m0 + q * NGW; if (m < MTOK) {
              const f32x4* xr = (const f32x4*)(P.out + (size_t)m * DM) + lane; r[q] = F.ss[m];
#pragma unroll
              for (int j = 0; j < 4; ++j) v[q][j] = xr[64 * j]; } }
#pragma unroll
          for (int q = 0; q < 4; ++q) { const int m = m0 + q * NGW; if (m < MTOK) {
              f32x4* xr = (f32x4*)(P.out + (size_t)m * DM) + lane; const float rr = 1.f / sqrtf(r[q] * (1.f / DM) + EPS);
#pragma unroll
              for (int j = 0; j < 4; ++j) xr[64 * j] = v[q][j] * rr * gv[j]; } }
      } }
}

extern "C" void kernel_launch(void* const* d_in, const int* in_sizes, int n_in, void* d_out, int out_size, void* d_ws, size_t ws_size, hipStream_t stream) {
    static int grid_blocks = 0;
    if (!grid_blocks) {
        int dev = 0, cus = 0, per_cu = 0;
        (void)hipGetDevice(&dev);
        (void)hipDeviceGetAttribute(&cus, hipDeviceAttributeMultiprocessorCount, dev);
        (void)hipFuncSetAttribute((const void*)fwd_megakernel, hipFuncAttributeMaxDynamicSharedMemorySize, LDS_BYTES);
        (void)hipOccupancyMaxActiveBlocksPerMultiprocessor(&per_cu, (const void*)fwd_megakernel, NTHREADS, LDS_BYTES);
        if (per_cu < 1) { fprintf(stderr, "occupancy query says %d blocks/CU; using 1\n", per_cu); per_cu = 1; }
        (void)hipGetLastError();
        grid_blocks = cus * per_cu;
    }
    Params p{};
    p.xp = (const float*)d_in[0]; p.xs = (const float*)d_in[1]; p.cache = (const float*)d_in[2]; p.norm_g = (const float*)d_in[3]; p.w_in = (const float*)d_in[4];
    p.w_pool = (const float*)d_in[5]; p.pool_scale = (const float*)d_in[6]; p.ln_g = (const float*)d_in[7]; p.ln_b = (const float*)d_in[8]; p.w_s = (const float*)d_in[9];
    p.b_s = (const float*)d_in[10]; p.w_a = (const float*)d_in[11]; p.w_b = (const float*)d_in[12]; p.w_o = (const float*)d_in[13]; p.final_g = (const float*)d_in[14];
    p.out = (float*)d_out; p.ws = (unsigned char*)d_ws;
    (void)hipMemsetAsync((char*)d_ws + WS_BAR, 0, WS_BAR_BYTES, stream);
    void* args[] = {&p};
    hipError_t e = hipLaunchCooperativeKernel((const void*)fwd_megakernel, dim3(grid_blocks), dim3(NTHREADS), args, LDS_BYTES, stream);
    if (e != hipSuccess) fprintf(stderr, "cooperative launch failed: %s (grid %d)\n", hipGetErrorString(e), grid_blocks);
}
```

```cpp
#include <hip/hip_runtime.h>
#include <hip/hip_cooperative_groups.h>
#include <cstdio>
#include <cstdint>
namespace cg = cooperative_groups;

#define LAS __attribute__((address_space(3)))
typedef unsigned short bf16_t;
typedef short bf16x8 __attribute__((ext_vector_type(8)));
typedef float f32x4 __attribute__((ext_vector_type(4)));
typedef unsigned u32x4 __attribute__((ext_vector_type(4)));

constexpr int DM = 1024, NP = 4 * 8192, NS = 32 * 64, MTOK = NP + NS, DIN = 4608, SEQ = 8192;
constexpr int C_A = 0, C_GA = 512, C_U = 1024, C_V = 1536, C_GB = 2048, C_RA = 2560, C_RB = 3584;
constexpr float EPS = 1e-6f;
constexpr size_t OUT_YS = (size_t)NP * DM, OUT_SPP = (size_t)MTOK * DM, OUT_SPS = OUT_SPP + 4 * 15 * 512, OUT_SV = OUT_SPS + 32 * 15 * 512;
constexpr size_t MiB = 1u << 20;
constexpr size_t WS_VSTAT = 0, WS_SS = 512 * 1024, WS_BAR = 768 * 1024, WS_BAR_BYTES = 16384, WS_WIN = 1 * MiB, WS_WAB = 10 * MiB, WS_WO = 12 * MiB, WS_WPOOL = 14 * MiB, WS_WSB = 14 * MiB + 131072;
constexpr size_t WS_H = 16 * MiB, WS_T = 84 * MiB, WS_PROJ = 152 * MiB;
constexpr int NWAVES = 8, NTHREADS = 512;
constexpr int LDS_BYTES = 155648;

__device__ __forceinline__ unsigned cvt_pk_bf16(float lo, float hi) { unsigned r; asm volatile("v_cvt_pk_bf16_f32 %0, %1, %2" : "=v"(r) : "v"(lo), "v"(hi)); return r; }
__device__ __forceinline__ float bf_lo(unsigned w) { return __uint_as_float(w << 16); }
__device__ __forceinline__ float bf_hi(unsigned w) { return __uint_as_float(w & 0xffff0000u); }
__device__ __forceinline__ float sigmoidf_fast(float x) { return __builtin_amdgcn_rcpf(1.f + __builtin_amdgcn_exp2f(-1.44269504f * x)); }
__device__ __forceinline__ u32x4 pack8(const f32x4 a, const f32x4 b) { u32x4 w; w.x = cvt_pk_bf16(a[0], a[1]); w.y = cvt_pk_bf16(a[2], a[3]); w.z = cvt_pk_bf16(b[0], b[1]); w.w = cvt_pk_bf16(b[2], b[3]); return w; }
__device__ __forceinline__ void unpack8(const u32x4 w, f32x4& a, f32x4& b) { a = (f32x4){bf_lo(w.x), bf_hi(w.x), bf_lo(w.y), bf_hi(w.y)}; b = (f32x4){bf_lo(w.z), bf_hi(w.z), bf_lo(w.w), bf_hi(w.w)}; }

namespace pg8 {
constexpr int BM = 256, BK = 64, HALF = 128, HTB = HALF * BK * 2, STAGE_BYTES = 8 * HTB, NXCD = 8, WGM = 8;
__host__ __device__ __forceinline__ int lds_byte(int r, int c) { const int st = (r >> 4) * 2 + (c >> 5), rr = r & 15, cc = c & 31, ob = rr * 64 + cc * 2; return st * 1024 + (ob ^ (((ob >> 9) & 1) << 5)); }
__host__ __device__ __forceinline__ void stage_rc(int b, int& R, int& C) { const int st = b / 1024, sb = b % 1024, swz = sb ^ (((sb >> 9) & 1) << 5); R = (st >> 1) * 16 + swz / 64; C = (st & 1) * 32 + (swz % 64) / 2; }
__host__ __device__ __forceinline__ int perm32(int rho) { const int n = rho >> 4, i = rho & 15; return 8 * (i >> 2) + 4 * n + (i & 3); }

struct Unit { int pm, pn, kh; };
struct Gemm { const bf16_t* A; const bf16_t* Bt; int lda, ldb, nt, khA, khB; };

struct Order {
    int nM, nN, nwg, G, c, nkh;
    __device__ void init(int M, int N, int G_, int c_, int nkh_) { nM = M / BM; nN = N / BM; nwg = nM * nN; G = G_; c = c_; nkh = nkh_; }
    __device__ bool next(int i, Unit& u) const {
        const int ti = (nkh == 2) ? (i >> 1) : i; u.kh = (nkh == 2) ? (i & 1) : 0;
        const long L = (long)ti * G + c; if (L >= nwg) return false;
        int wgid = (int)L; { const int q = nwg / NXCD, r = nwg % NXCD, xcd = wgid % NXCD, off = wgid / NXCD; wgid = (xcd < r ? xcd * (q + 1) : r * (q + 1) + (xcd - r) * q) + off; }
        const int nig = WGM * nN, gid = wgid / nig, fm = gid * WGM, gsz = (nM - fm) < WGM ? (nM - fm) : WGM;
        u.pm = fm + ((wgid % nig) % gsz); u.pn = (wgid % nig) / gsz; return true;
    }
};

template <class Epi, class Sched>
__device__ __forceinline__ void gemm_phase(LAS unsigned char* lds, const Gemm g, const Sched& S, const Epi& E, const unsigned delay_ticks) {
    if (delay_ticks) {
        const unsigned long long t0 = __builtin_amdgcn_s_memrealtime();
        while (__builtin_amdgcn_s_memrealtime() - t0 < (unsigned long long)delay_ticks) __builtin_amdgcn_s_sleep(32);
    }
    const int tid = threadIdx.x, wid = __builtin_amdgcn_readfirstlane(tid >> 6), lane = tid & 63, wr = wid >> 2, wc = wid & 3, fr = lane & 15, fq = lane >> 4;
    const int nt = g.nt;
    unsigned voffA[2], voffB[2];
#pragma unroll
    for (int i = 0; i < 2; ++i) { int R, C; stage_rc(tid * 16 + i * 8192, R, C); const int Rb = (R & ~31) + perm32(R & 31);
        voffA[i] = (unsigned)(R * g.lda + C) * 2u; voffB[i] = (unsigned)(Rb * g.ldb + C) * 2u; }
    const size_t kstep = (size_t)(BK * 2);
    const size_t hstepA = (size_t)HALF * g.lda * 2, hstepB = (size_t)HALF * g.ldb * 2;
    const size_t tstepA = 2 * hstepA, tstepB = 2 * hstepB;
    const unsigned ldsw = (unsigned)wid * 1024u;
    const int aoff = lds_byte(wr * 64 + fr, fq * 8), boff = lds_byte(wc * 32 + fr, fq * 8);
#define PG8_SA(b, h) (((b) * 2 + (h)) * HTB)
#define PG8_SB(b, h) ((4 + (b) * 2 + (h)) * HTB)
#define PG8_STAGE(bufoff, gbase, voff) do { _Pragma("unroll") for (int _i = 0; _i < 2; ++_i) \
        __builtin_amdgcn_global_load_lds((const unsigned*)((const char*)(gbase) + (voff)[_i]), (LAS unsigned*)(lds + (bufoff) + ldsw + _i * 8192), 16, 0, 0); } while (0)
#define PG8_LDA(dst, b, h) do { _Pragma("unroll") for (int m = 0; m < 4; ++m) _Pragma("unroll") for (int k = 0; k < 2; ++k) dst[m][k] = *(const LAS bf16x8*)(lds + PG8_SA(b, h) + aoff + m * 2048 + k * 1024); } while (0)
#define PG8_LDB(dst, b, h) do { _Pragma("unroll") for (int n = 0; n < 2; ++n) _Pragma("unroll") for (int k = 0; k < 2; ++k) dst[n][k] = *(const LAS bf16x8*)(lds + PG8_SB(b, h) + boff + n * 2048 + k * 1024); } while (0)
#define PG8_MMA(ai, bj, At, Bt) do { __builtin_amdgcn_s_setprio(1); _Pragma("unroll") for (int m = 0; m < 4; ++m) _Pragma("unroll") for (int n = 0; n < 2; ++n) _Pragma("unroll") for (int k = 0; k < 2; ++k) \
        acc[ai][bj][m][n] = __builtin_amdgcn_mfma_f32_16x16x32_bf16(Bt[n][k], At[m][k], acc[ai][bj][m][n], 0, 0, 0); __builtin_amdgcn_s_setprio(0); } while (0)
#define PG8_WAIT_V(n) asm volatile("s_waitcnt vmcnt(" #n ")" ::: "memory")
#define PG8_WAIT_L(n) asm volatile("s_waitcnt lgkmcnt(" #n ")" ::: "memory")
#define PG8_BAR __builtin_amdgcn_s_barrier()
#define PG8_SCHED __builtin_amdgcn_sched_barrier(0)
#define PG8_ZERO() do { _Pragma("unroll") for (int a = 0; a < 2; ++a) _Pragma("unroll") for (int b = 0; b < 2; ++b) _Pragma("unroll") for (int m = 0; m < 4; ++m) _Pragma("unroll") for (int n = 0; n < 2; ++n) acc[a][b][m][n] = (f32x4){0.f, 0.f, 0.f, 0.f}; } while (0)
    Unit cur, nxt; int ui = 0;
    if (!S.next(0, cur)) return;
    f32x4 acc[2][2][4][2];
    PG8_ZERO();
    bf16x8 At[4][2], B0[2][2], B1[2][2];
    const char* cA = (const char*)g.A + (size_t)cur.pm * tstepA + (size_t)cur.kh * g.khA; const char* cB = (const char*)g.Bt + (size_t)cur.pn * tstepB + (size_t)cur.kh * g.khB;
    PG8_STAGE(PG8_SB(0, 0), cB, voffB); PG8_STAGE(PG8_SB(0, 1), cB + hstepB, voffB); PG8_STAGE(PG8_SA(0, 0), cA, voffA); PG8_STAGE(PG8_SA(0, 1), cA + hstepA, voffA);
    if (wr == 1) PG8_BAR;
    PG8_WAIT_V(2); PG8_BAR;
    PG8_STAGE(PG8_SB(1, 0), cB + kstep, voffB); PG8_STAGE(PG8_SA(1, 0), cA + kstep, voffA); PG8_STAGE(PG8_SB(1, 1), cB + hstepB + kstep, voffB);
    PG8_WAIT_V(6); PG8_BAR;
    for (;;) {
        const bool has_next = S.next(ui + 1, nxt);
        const char* nA = has_next ? (const char*)g.A + (size_t)nxt.pm * tstepA + (size_t)nxt.kh * g.khA : cA; const char* nB = has_next ? (const char*)g.Bt + (size_t)nxt.pn * tstepB + (size_t)nxt.kh * g.khB : cB;
        for (int t = 0; t < nt; t += 2) {
            const bool last = (t == nt - 2);
            const char* a1 = cA + (size_t)(t + 1) * kstep;
            const char* a2 = last ? nA : cA + (size_t)(t + 2) * kstep; const char* b2 = last ? nB : cB + (size_t)(t + 2) * kstep;
            const char* a3 = a2 + kstep; const char* b3 = b2 + kstep;
            PG8_LDB(B0, 0, 0); PG8_LDB(B1, 0, 1); PG8_SCHED; PG8_LDA(At, 0, 0); PG8_STAGE(PG8_SA(1, 1), a1 + hstepA, voffA);
            PG8_WAIT_V(8); PG8_WAIT_L(0); PG8_BAR; PG8_MMA(0, 0, At, B0); PG8_MMA(0, 1, At, B1); PG8_BAR; PG8_SCHED;
            PG8_LDA(At, 0, 1); PG8_STAGE(PG8_SB(0, 0), b2, voffB); PG8_STAGE(PG8_SB(0, 1), b2 + hstepB, voffB); PG8_STAGE(PG8_SA(0, 0), a2, voffA);
            PG8_WAIT_V(8); PG8_WAIT_L(0); PG8_BAR; PG8_MMA(1, 0, At, B0); PG8_MMA(1, 1, At, B1); PG8_BAR; PG8_SCHED;
            PG8_LDB(B0, 1, 0); PG8_LDB(B1, 1, 1); PG8_SCHED; PG8_LDA(At, 1, 0); PG8_STAGE(PG8_SA(0, 1), a2 + hstepA, voffA);
            PG8_WAIT_V(8); PG8_WAIT_L(0); PG8_BAR; PG8_MMA(0, 0, At, B0); PG8_MMA(0, 1, At, B1); PG8_BAR; PG8_SCHED;
            PG8_LDA(At, 1, 1); PG8_STAGE(PG8_SB(1, 0), b3, voffB); PG8_STAGE(PG8_SB(1, 1), b3 + hstepB, voffB); PG8_STAGE(PG8_SA(1, 0), a3, voffA);
            PG8_WAIT_V(8); PG8_WAIT_L(0); PG8_BAR; PG8_MMA(1, 0, At, B0); PG8_MMA(1, 1, At, B1); PG8_BAR; PG8_SCHED;
        }
        if (wr == 0) PG8_BAR;
        E(acc, cur, wr, wc, fr, fq);
        if (!has_next) break;
        if (!Epi::keep(cur)) PG8_ZERO();
        cur = nxt; cA = nA; cB = nB; ++ui;
        if (wr == 1) PG8_BAR;
    }
    PG8_WAIT_V(0);
    PG8_BAR;
#undef PG8_SA
#undef PG8_SB
#undef PG8_STAGE
#undef PG8_LDA
#undef PG8_LDB
#undef PG8_MMA
#undef PG8_WAIT_V
#undef PG8_WAIT_L
#undef PG8_BAR
#undef PG8_SCHED
#undef PG8_ZERO
}
}
using pg8::Unit;

struct EpiProj {
    bf16_t* proj; float* vstat;
    static __device__ __forceinline__ bool keep(const Unit&) { return false; }
    __device__ __forceinline__ void operator()(f32x4 (&acc)[2][2][4][2], const Unit& u, int wr, int wc, int fr, int fq) const {
        const int row0 = u.pm * 256 + wr * 64 + fr, col0 = u.pn * 256 + wc * 32 + 8 * fq;
        const int pn = u.pn;
        const int kind = (pn >= 10) ? 2 : ((pn == 2 || pn == 3 || pn == 8 || pn == 9) ? 1 : ((pn == 6 || pn == 7) ? 3 : 0));
#pragma unroll
        for (int ai = 0; ai < 2; ++ai)
#pragma unroll
            for (int m = 0; m < 4; ++m) {
                const int row = row0 + ai * 128 + m * 16;
                bf16_t* rowp = proj + (size_t)row * DIN + col0;
                float s1 = 0.f, s2 = 0.f;
                if (kind == 2) {
#pragma unroll
                    for (int n = 0; n < 2; ++n)
#pragma unroll
                        for (int e = 0; e < 4; ++e) {
                            const float ea = __builtin_amdgcn_exp2f(-1.44269504f * acc[ai][0][m][n][e]), eb = __builtin_amdgcn_exp2f(-1.44269504f * acc[ai][1][m][n][e]);
                            acc[ai][0][m][n][e] = (1.f + eb) * __builtin_amdgcn_rcpf(1.f + ea); acc[ai][1][m][n][e] = __builtin_amdgcn_rcpf(1.f + eb);
                        }
                }
#pragma unroll
                for (int bj = 0; bj < 2; ++bj) {
                    f32x4 v0 = acc[ai][bj][m][0], v1 = acc[ai][bj][m][1];
                    if (kind == 1) {
#pragma unroll
                        for (int e = 0; e < 4; ++e) { v0[e] = v0[e] * sigmoidf_fast(v0[e]); v1[e] = v1[e] * sigmoidf_fast(v1[e]); }
                    } else if (kind == 3) {
#pragma unroll
                        for (int e = 0; e < 4; ++e) { s1 += v0[e] + v1[e]; s2 += v0[e] * v0[e] + v1[e] * v1[e]; }
                    }
                    *(u32x4*)(rowp + bj * 128) = pack8(v0, v1);
                }
                if (kind == 3) {
                    s1 += __shfl_xor(s1, 16); s1 += __shfl_xor(s1, 32); s2 += __shfl_xor(s2, 16); s2 += __shfl_xor(s2, 32);
                    if (fq == 0) { atomicAdd(vstat + 2 * row, s1); atomicAdd(vstat + 2 * row + 1, s2); }
                }
            }
    }
};
struct EpiMerge {
    const bf16_t* proj; bf16_t* outm;
    static __device__ __forceinline__ bool keep(const Unit& u) { return u.kh == 0; }
    __device__ __forceinline__ void operator()(f32x4 (&acc)[2][2][4][2], const Unit& u, int wr, int wc, int fr, int fq) const {
        const int row0 = u.pm * 256 + wr * 64 + fr, col0 = u.pn * 256 + wc * 32 + 8 * fq;
        const int gcol = C_RA + 512 * u.pn + wc * 32 + 8 * fq + (u.kh == 0 ? 0 : 128);
#pragma unroll
        for (int ai = 0; ai < 2; ++ai) {
            u32x4 gt[4][2];
#pragma unroll
            for (int m = 0; m < 4; ++m)
#pragma unroll
                for (int bj = 0; bj < 2; ++bj)
                    gt[m][bj] = *(const u32x4*)(proj + (size_t)(row0 + ai * 128 + m * 16) * DIN + gcol + 256 * bj);
            __builtin_amdgcn_sched_barrier(0);
            if (u.kh == 0) {
#pragma unroll
                for (int m = 0; m < 4; ++m)
#pragma unroll
                    for (int bj = 0; bj < 2; ++bj) { f32x4 r0, r1; unpack8(gt[m][bj], r0, r1); acc[ai][bj][m][0] *= r0; acc[ai][bj][m][1] *= r1; }
            } else {
#pragma unroll
                for (int m = 0; m < 4; ++m)
#pragma unroll
                    for (int bj = 0; bj < 2; ++bj) {
                        const int row = row0 + ai * 128 + m * 16, c = col0 + bj * 128;
                        f32x4 b0, b1; unpack8(gt[m][bj], b0, b1);
                        *(u32x4*)(outm + (size_t)row * DM + c) = pack8(acc[ai][bj][m][0] * b0, acc[ai][bj][m][1] * b1);
                    }
            }
            __builtin_amdgcn_sched_barrier(0);
        }
    }
};
struct EpiOut {
    const float* xp; const float* xs; float* out; float* ss;
    static __device__ __forceinline__ bool keep(const Unit&) { return false; }
    __device__ __forceinline__ void operator()(f32x4 (&acc)[2][2][4][2], const Unit& u, int wr, int wc, int fr, int fq) const {
        const int row0 = u.pm * 256 + wr * 64 + fr, col0 = u.pn * 256 + wc * 32 + 8 * fq;
        const float* xbase = (u.pm * 256 < NP) ? xp : xs - (size_t)NP * DM;
#pragma unroll
        for (int ai = 0; ai < 2; ++ai) {
            f32x4 xv[4][2][2];
#pragma unroll
            for (int m = 0; m < 4; ++m)
#pragma unroll
                for (int bj = 0; bj < 2; ++bj) {
                    const float* xr = xbase + (size_t)(row0 + ai * 128 + m * 16) * DM + col0 + bj * 128;
                    xv[m][bj][0] = *(const f32x4*)xr; xv[m][bj][1] = *(const f32x4*)(xr + 4);
                }
            __builtin_amdgcn_sched_barrier(0);
#pragma unroll
            for (int m = 0; m < 4; ++m) {
                const int row = row0 + ai * 128 + m * 16;
                float* orow = out + (size_t)row * DM;
                float q = 0.f;
#pragma unroll
                for (int bj = 0; bj < 2; ++bj) {
                    const int c = col0 + bj * 128;
                    const f32x4 o0 = xv[m][bj][0] + acc[ai][bj][m][0], o1 = xv[m][bj][1] + acc[ai][bj][m][1];
                    *(f32x4*)(orow + c) = o0; *(f32x4*)(orow + c + 4) = o1;
                    q += (o0[0] * o0[0] + o0[1] * o0[1]) + (o0[2] * o0[2] + o0[3] * o0[3]) + (o1[0] * o1[0] + o1[1] * o1[1]) + (o1[2] * o1[2] + o1[3] * o1[3]);
                }
                q += __shfl_xor(q, 16); q += __shfl_xor(q, 32);
                if (fq == 0) atomicAdd(ss + row, q);
            }
            __builtin_amdgcn_sched_barrier(0);
        }
    }
};

struct Params {
    const float *xp, *xs, *cache, *norm_g, *w_in, *w_pool, *pool_scale, *ln_g, *ln_b, *w_s, *b_s, *w_a, *w_b, *w_o, *final_g;
    float* out; unsigned char* ws;
};
struct Frame {
    LAS unsigned char* lds; int tid, lane, wave, vcu, G;
    bf16_t *Win_t, *Wab_t, *Wo_t, *Wpool_t, *Ws_b, *H, *T, *PROJ;
    float *vstat, *ss;
};
#define LDS_WAIT() asm volatile("s_waitcnt lgkmcnt(0)" ::: "memory")
__device__ __forceinline__ float wave_sum(float v) {
#pragma unroll
    for (int o = 1; o < 64; o <<= 1) v += __shfl_xor(v, o);
    return v;
}
__device__ __forceinline__ void transpose_item(const float* W, int N, bf16_t* WT, int ldt, LAS float* scr, int item, int nblk, int lane, int perm) {
    const int kb = item / nblk, nb = item % nblk, k0 = 64 * kb, n0 = 32 * nb;
    int nd = n0;
    if (perm && n0 >= C_RA) { const int isb = n0 >= C_RB ? 1 : 0, rel = n0 - (isb ? C_RB : C_RA), k = rel >> 7; nd = C_RA + 256 * k + 128 * isb + (rel & 127); }
#pragma unroll 8
    for (int i = 0; i < 32; ++i) { const int kk = 2 * i + (lane >> 5); scr[kk * 33 + (lane & 31)] = W[(size_t)(k0 + kk) * N + n0 + (lane & 31)]; }
    LDS_WAIT(); asm volatile("" ::: "memory");
    const int c = lane & 7;
#pragma unroll
    for (int j = 0; j < 4; ++j) { const int n = (lane >> 3) + 8 * j; const LAS float* s = scr + (8 * c) * 33 + n;
        u32x4 o; o.x = cvt_pk_bf16(s[0 * 33], s[1 * 33]); o.y = cvt_pk_bf16(s[2 * 33], s[3 * 33]); o.z = cvt_pk_bf16(s[4 * 33], s[5 * 33]); o.w = cvt_pk_bf16(s[6 * 33], s[7 * 33]);
        *(u32x4*)(WT + (size_t)(nd + n) * ldt + k0 + 8 * c) = o; }
    LDS_WAIT(); asm volatile("" ::: "memory");
}

__device__ __forceinline__ void p0_prologue(const Params& P, Frame& F) {
    LAS float* scr = (LAS float*)(F.lds + F.wave * 16384);
    const int gw = F.vcu * NWAVES + F.wave, NGW = F.G * NWAVES, lane = F.lane;
    constexpr int I_IN = 16 * 144, I_A = 8 * 32, I_O = 16 * 32, I_P = 2 * 4;
    constexpr int NITEMS = I_IN + 2 * I_A + I_O + 4 * I_P;
    for (int it = gw; it < NITEMS; it += NGW) {
        int r = it;
        if (r < I_IN) { transpose_item(P.w_in, DIN, F.Win_t, 1024, scr, r, 144, lane, 1); continue; } r -= I_IN;
        if (r < I_A) { transpose_item(P.w_a, 1024, F.Wab_t, 1024, scr, r, 32, lane, 0); continue; } r -= I_A;
        if (r < I_A) { transpose_item(P.w_b, 1024, F.Wab_t + 512, 1024, scr, r, 32, lane, 0); continue; } r -= I_A;
        if (r < I_O) { transpose_item(P.w_o, 1024, F.Wo_t, 1024, scr, r, 32, lane, 0); continue; } r -= I_O;
        { const int g = r / I_P; transpose_item(P.w_pool + g * 16384, 128, F.Wpool_t + g * 16384, 128, scr, r % I_P, 4, lane, 0); }
    }
    const int gt = F.vcu * NTHREADS + F.tid, NGT = F.G * NTHREADS;
    for (int e = gt; e < 4 * 128 * 128 / 2; e += NGT) { const int i = (e >> 6) & 127, j = (e & 63) * 2; const float lo = P.w_s[2 * e], hi = P.w_s[2 * e + 1]; const bool z = (i < 64 && j >= 64);
        ((unsigned*)F.Ws_b)[e] = z ? 0u : cvt_pk_bf16(lo, hi); }
    for (int e = gt; e < MTOK * 2; e += NGT) F.vstat[e] = 0.f;
    for (int e = gt; e < MTOK; e += NGT) F.ss[e] = 0.f;
    f32x4 gv[4];
#pragma unroll
    for (int j = 0; j < 4; ++j) gv[j] = *((const f32x4*)P.norm_g + lane + 64 * j);
    for (int m0 = gw; m0 < MTOK; m0 += 4 * NGW) {
        f32x4 v[4][4];
#pragma unroll
        for (int q = 0; q < 4; ++q) { const int m = m0 + q * NGW; if (m < MTOK) {
            const float* xrow = (m < NP) ? P.xp + (size_t)m * DM : P.xs + (size_t)(m - NP) * DM;
#pragma unroll
            for (int j = 0; j < 4; ++j) v[q][j] = ((const f32x4*)xrow)[lane + 64 * j]; } }
#pragma unroll
        for (int q = 0; q < 4; ++q) { const int m = m0 + q * NGW; if (m < MTOK) {
            float s = 0.f;
#pragma unroll
            for (int j = 0; j < 4; ++j) s += (v[q][j].x * v[q][j].x + v[q][j].y * v[q][j].y) + (v[q][j].z * v[q][j].z + v[q][j].w * v[q][j].w);
            const float r = 1.f / sqrtf(wave_sum(s) * (1.f / DM) + EPS);
            unsigned long long* o8 = (unsigned long long*)(F.H + (size_t)m * DM) + lane;
#pragma unroll
            for (int j = 0; j < 4; ++j) { const f32x4 h = v[q][j] * r * gv[j]; o8[64 * j] = (unsigned long long)cvt_pk_bf16(h.x, h.y) | ((unsigned long long)cvt_pk_bf16(h.z, h.w) << 32); } } }
    }
}

struct PoolRegs { f32x4 lo[5], hi[5]; };
__device__ __forceinline__ void pool_load(const Params& P, const Frame& F, int rt, int g, PoolRegs& R) {
    const int tid = F.tid, lane = F.lane, fr = lane & 15, fq = lane >> 4, wd = F.wave & 3, wt = F.wave >> 2;
    const int R0 = rt * 128; const bool smp = R0 >= NP;
#pragma unroll
    for (int q = 0; q < 5; ++q) {
        const int p = tid + 512 * q, seg = p / 1280, rem = p - seg * 1280, r = rem >> 4, cb = rem & 15, rel = r - 16;
        const int segrow = R0 + 64 * seg;
        f32x4 lo = (f32x4){0.f, 0.f, 0.f, 0.f}, hi = lo;
        if (rel >= 0 || (!smp && (segrow & (SEQ - 1)) != 0)) {
            unpack8(*(const u32x4*)(F.PROJ + (size_t)(segrow + rel) * DIN + C_A + g * 128 + cb * 8), lo, hi);
        } else if (smp && rel >= -15) {
            const int s = (segrow - NP) >> 6; const float* cp = P.cache + ((size_t)s * 15 + (15 + rel)) * 512 + g * 128 + cb * 8;
            lo = *(const f32x4*)cp; hi = *(const f32x4*)(cp + 4);
        }
        R.lo[q] = lo; R.hi[q] = hi;
    }
}
__device__ __forceinline__ void pool_stream(const Params& P, Frame& F, int rt0, int rt_step, int g) {
    const int tid = F.tid, lane = F.lane, fr = lane & 15, fq = lane >> 4, wd = F.wave & 3, wt = F.wave >> 2;
    LAS float* aT = (LAS float*)F.lds;
    LAS bf16_t* PA = (LAS bf16_t*)(F.lds + 81920);
    bf16x8 wA[2][4];
    { const bf16_t* wp = F.Wpool_t + g * 16384;
#pragma unroll
      for (int n = 0; n < 2; ++n) { const int d = 32 * wd + 8 * (fr >> 2) + 4 * n + (fr & 3);
#pragma unroll
        for (int kk = 0; kk < 4; ++kk) wA[n][kk] = *(const bf16x8*)(wp + d * 128 + kk * 32 + fq * 8); } }
    const int d0 = g * 128 + 32 * wd + 8 * fq;
    const f32x4 ps0 = *(const f32x4*)(P.pool_scale + d0), ps1 = *(const f32x4*)(P.pool_scale + d0 + 4);
    constexpr int NRT = MTOK / 128;
    PoolRegs cur; u32x4 gate[4];
    if (rt0 < NRT) { pool_load(P, F, rt0, g, cur);
#pragma unroll
        for (int nb = 0; nb < 4; ++nb) gate[nb] = *(const u32x4*)(F.PROJ + (size_t)(rt0 * 128 + 64 * wt + 16 * nb + fr) * DIN + C_GA + d0); }
    for (int rt = rt0; rt < NRT; rt += rt_step) {
        const int R0 = rt * 128; const bool smp = R0 >= NP;
#pragma unroll
        for (int q = 0; q < 5; ++q) {
            const int p = tid + 512 * q, seg = p / 1280, rem = p - seg * 1280, r = rem >> 4, cb = rem & 15;
            LAS float* dst = aT + (seg * 80 + r) * 128 + cb * 8;
            *(LAS f32x4*)dst = cur.lo[q]; *(LAS f32x4*)(dst + 4) = cur.hi[q];
        }
        __syncthreads();
        if (rt + rt_step < NRT) pool_load(P, F, rt + rt_step, g, cur);
        {
            const int c = tid & 127, q = tid >> 7, seg = q >> 1, k0 = 32 * (q & 1), w = 2 << g;
            const int segrow = R0 + 64 * seg, tpos0 = segrow & (SEQ - 1);
            const LAS float* base = aT + (seg * 80 + 16) * 128 + c;
            float S = 0.f;
            for (int d = 1; d < w; ++d) S += base[(k0 - d) * 128];
            const int cap = smp ? 0 : w;
            LAS bf16_t* pa = PA + (64 * seg + k0) * 136 + c;
#pragma unroll 8
            for (int kk = 0; kk < 32; ++kk) {
                const int k = k0 + kk;
                const float a = base[k * 128], sub = base[(k - w + 1) * 128]; S += a;
                const int cnt = smp ? w : min(tpos0 + k + 1, cap);
                const float o = S * __builtin_amdgcn_rcpf((float)cnt) - a;
                pa[kk * 136] = (bf16_t)(cvt_pk_bf16(o, 0.f) & 0xffffu);
                S -= sub;
            }
            if (smp) { const int s = (segrow - NP) >> 6;
                for (int k = max(k0, 49); k < k0 + 32; ++k) P.out[OUT_SPS + ((size_t)s * 15 + (k - 49)) * 512 + g * 128 + c] = base[k * 128]; }
            else if (tpos0 + 64 > SEQ - 15) {
                for (int k = k0; k < k0 + 32; ++k) { const int t = tpos0 + k; if (t >= SEQ - 15) P.out[OUT_SPP + ((size_t)(R0 >> 13) * 15 + (t - (SEQ - 15))) * 512 + g * 128 + c] = base[k * 128]; } }
        }
        __syncthreads();
        f32x4 acc[4][2];
#pragma unroll
        for (int nb = 0; nb < 4; ++nb) { acc[nb][0] = (f32x4){0.f, 0.f, 0.f, 0.f}; acc[nb][1] = acc[nb][0]; }
#pragma unroll
        for (int nb = 0; nb < 4; ++nb) {
            const LAS bf16_t* pr = PA + (64 * wt + 16 * nb + fr) * 136 + fq * 8;
#pragma unroll
            for (int kk = 0; kk < 4; ++kk) {
                const bf16x8 b = *(const LAS bf16x8*)(pr + kk * 32);
                acc[nb][0] = __builtin_amdgcn_mfma_f32_16x16x32_bf16(wA[0][kk], b, acc[nb][0], 0, 0, 0);
                acc[nb][1] = __builtin_amdgcn_mfma_f32_16x16x32_bf16(wA[1][kk], b, acc[nb][1], 0, 0, 0);
            }
        }
#pragma unroll
        for (int nb = 0; nb < 4; ++nb) {
            const int row = R0 + 64 * wt + 16 * nb + fr;
            f32x4 s0, s1; unpack8(gate[nb], s0, s1);
            *(u32x4*)(F.T + (size_t)row * DM + d0) = pack8(acc[nb][0] * ps0 * s0, acc[nb][1] * ps1 * s1);
        }
        if (rt + rt_step < NRT) {
#pragma unroll
            for (int nb = 0; nb < 4; ++nb) gate[nb] = *(const u32x4*)(F.PROJ + (size_t)((rt + rt_step) * 128 + 64 * wt + 16 * nb + fr) * DIN + C_GA + d0); }
    }
}
struct SguRegs { u32x4 v[4]; float s1[4], s2[4]; };
struct SguGates { u32x4 gu[4], gg[4]; float bs[4]; };
__device__ __forceinline__ void sgu_load(const Params& P, const Frame& F, int rt, int g, SguRegs& R) {
    const int tid = F.tid, lane = F.lane, fr = lane & 15, fq = lane >> 4, wcg = F.wave & 3, wt = F.wave >> 2;
    const int R0 = rt * 128, cb = tid & 15;
#pragma unroll
    for (int q = 0; q < 4; ++q) { const int row = R0 + (tid >> 4) + 32 * q;
        R.v[q] = *(const u32x4*)(F.PROJ + (size_t)row * DIN + C_V + g * 128 + cb * 8); R.s1[q] = F.vstat[2 * row]; R.s2[q] = F.vstat[2 * row + 1]; }
}
__device__ __forceinline__ void sgu_load_gates(const Params& P, const Frame& F, int rt, int g, SguGates& R) {
    const int lane = F.lane, fr = lane & 15, fq = lane >> 4, wcg = F.wave & 3, wt = F.wave >> 2;
    const int R0 = rt * 128; const bool smp = R0 >= NP;
    const int c0 = g * 128 + 32 * wcg + 8 * fq;
#pragma unroll
    for (int nb = 0; nb < 4; ++nb) { const int i = 64 * wt + 16 * nb + fr; const bf16_t* pr = F.PROJ + (size_t)(R0 + i) * DIN;
        R.gu[nb] = *(const u32x4*)(pr + C_U + c0); R.gg[nb] = *(const u32x4*)(pr + C_GB + c0); R.bs[nb] = P.b_s[g * 128 + (smp ? (i & 63) : i)]; }
}
__device__ __forceinline__ void sgu_stream(const Params& P, Frame& F, int rt0, int rt_step, int g) {
    const int tid = F.tid, lane = F.lane, fr = lane & 15, fq = lane >> 4, wcg = F.wave & 3, wt = F.wave >> 2;
    LAS bf16_t* VH = (LAS bf16_t*)(F.lds + 116736);
    const bf16_t* wp = F.Ws_b + g * 16384;
    bf16x8 wB[4][4];
#pragma unroll
    for (int nb = 0; nb < 4; ++nb) { const int i = 64 * wt + 16 * nb + fr;
#pragma unroll
        for (int kk = 0; kk < 4; ++kk) wB[nb][kk] = (kk < 2 || wt == 1) ? *(const bf16x8*)(wp + i * 128 + kk * 32 + fq * 8) : (bf16x8){0, 0, 0, 0, 0, 0, 0, 0}; }
    const int cb = tid & 15, c0 = g * 128 + 32 * wcg + 8 * fq;
    const f32x4 lg0 = *(const f32x4*)(P.ln_g + g * 128 + cb * 8), lg1 = *(const f32x4*)(P.ln_g + g * 128 + cb * 8 + 4);
    const f32x4 lb0 = *(const f32x4*)(P.ln_b + g * 128 + cb * 8), lb1 = *(const f32x4*)(P.ln_b + g * 128 + cb * 8 + 4);
    constexpr int NRT = MTOK / 128;
    SguRegs cur; SguGates gt; if (rt0 < NRT) { sgu_load(P, F, rt0, g, cur); sgu_load_gates(P, F, rt0, g, gt); }
    bool w_is_smp = false;
    for (int rt = rt0; rt < NRT; rt += rt_step) {
        const int R0 = rt * 128; const bool smp = R0 >= NP;
        if (smp && !w_is_smp) {
            w_is_smp = true;
#pragma unroll
            for (int nb = 0; nb < 4; ++nb) { const int i = 16 * nb + fr;
#pragma unroll
                for (int kk = 0; kk < 4; ++kk) wB[nb][kk] = ((kk < 2) == (wt == 0)) ? *(const bf16x8*)(wp + i * 128 + (kk & 1) * 32 + fq * 8) : (bf16x8){0, 0, 0, 0, 0, 0, 0, 0}; }
        }
#pragma unroll
        for (int q = 0; q < 4; ++q) {
            const int j = (tid >> 4) + 32 * q, row = R0 + j;
            f32x4 v0, v1; unpack8(cur.v[q], v0, v1);
            const float mean = cur.s1[q] * (1.f / 512.f), var = fmaxf(cur.s2[q] * (1.f / 512.f) - mean * mean, 0.f), rstd = 1.f / sqrtf(var + EPS);
            v0 = (v0 - mean) * rstd * lg0 + lb0; v1 = (v1 - mean) * rstd * lg1 + lb1;
            if (smp) { float* o = P.out + OUT_SV + (size_t)(row - NP) * 512 + g * 128 + cb * 8; *(f32x4*)o = v0; *(f32x4*)(o + 4) = v1; }
            *(LAS u32x4*)(VH + j * 136 + cb * 8) = pack8(v0, v1);
        }
        __syncthreads();
        if (rt + rt_step < NRT) sgu_load(P, F, rt + rt_step, g, cur);
        f32x4 acc[4][2];
#pragma unroll
        for (int nb = 0; nb < 4; ++nb) { acc[nb][0] = (f32x4){0.f, 0.f, 0.f, 0.f}; acc[nb][1] = acc[nb][0]; }
#pragma unroll
        for (int kk = 0; kk < 4; ++kk) {
            const bool need = (kk < 2) ? (wt == 0 || !smp) : (wt == 1);
            if (need) {
                bf16x8 a[2];
#pragma unroll
                for (int n = 0; n < 2; ++n) { const int c = 32 * wcg + 8 * (fr >> 2) + 4 * n + (fr & 3); const LAS bf16_t* vp = VH + (kk * 32 + fq * 8) * 136 + c;
#pragma unroll
                    for (int e = 0; e < 8; ++e) a[n][e] = (short)vp[e * 136]; }
#pragma unroll
                for (int nb = 0; nb < 4; ++nb) {
                    acc[nb][0] = __builtin_amdgcn_mfma_f32_16x16x32_bf16(a[0], wB[nb][kk], acc[nb][0], 0, 0, 0);
                    acc[nb][1] = __builtin_amdgcn_mfma_f32_16x16x32_bf16(a[1], wB[nb][kk], acc[nb][1], 0, 0, 0);
                }
            }
        }
#pragma unroll
        for (int nb = 0; nb < 4; ++nb) {
            const int i = 64 * wt + 16 * nb + fr, row = R0 + i;
            const float bs = gt.bs[nb];
            f32x4 u0, u1, g0, g1; unpack8(gt.gu[nb], u0, u1); unpack8(gt.gg[nb], g0, g1);
            *(u32x4*)(F.T + (size_t)row * DM + 512 + c0) = pack8((acc[nb][0] + bs) * u0 * g0, (acc[nb][1] + bs) * u1 * g1);
        }
        if (rt + rt_step < NRT) sgu_load_gates(P, F, rt + rt_step, g, gt);
        __syncthreads();
    }
}

#define XB_TMO      128
#define XB_XCNT(j)  (256  + 64 * (j))
#define XB_XSUB(j)  (1280 + 64 * (j))
#define XB_XGEN(j)  (2304 + 64 * (j))
#define XB_TOP      3328
#define XB_TOPGEN   3392
#define XCD_BAR_WORDS 3456
#define XB_SPIN_CAP (1u << 18)
__device__ __forceinline__ unsigned xb_ld(unsigned* p)              { return __hip_atomic_load(p, __ATOMIC_RELAXED, __HIP_MEMORY_SCOPE_AGENT); }
__device__ __forceinline__ unsigned xb_add(unsigned* p, unsigned v) { return __hip_atomic_fetch_add(p, v, __ATOMIC_RELAXED, __HIP_MEMORY_SCOPE_AGENT); }
__device__ __forceinline__ unsigned xb_xcc_id() { return (unsigned)__builtin_amdgcn_s_getreg((3 << 11) | 20) & 0xFu; }
#define XB_SPIN(cond, bar) do { unsigned _sp = 0; while (cond) { __builtin_amdgcn_s_sleep(1); \
    if ((++_sp & 255u) == 0u) { if (xb_ld(&(bar)[XB_TMO])) break; if (_sp > XB_SPIN_CAP) { atomicAdd(&(bar)[XB_TMO], 1u); break; } } } } while (0)
struct XcdBarrier { unsigned* bar; unsigned x; volatile LAS unsigned* st; };
__device__ __forceinline__ XcdBarrier xcd_barrier_post(unsigned* bar, volatile LAS unsigned* st) {
    XcdBarrier b; b.bar = bar; b.x = xb_xcc_id(); b.st = st;
    if (threadIdx.x == 0) (void)xb_add(&bar[XB_XCNT(b.x)], 1u);
    return b;
}
__device__ __forceinline__ void xcd_barrier_complete(unsigned* bar, unsigned x, unsigned& nloc, unsigned& nx) {
    const unsigned G = gridDim.x * gridDim.y * gridDim.z;
    unsigned sum, cnt, mine, sp = 0u;
    for (;;) {
        sum = 0u; cnt = 0u; mine = 0u;
#pragma unroll
        for (unsigned j = 0; j < 16; ++j) { const unsigned c = xb_ld(&bar[XB_XCNT(j)]); sum += c; cnt += (c > 0u) ? 1u : 0u; mine = (j == x) ? c : mine; }
        if (sum == G) break;
        __builtin_amdgcn_s_sleep(1);
        if ((++sp & 255u) == 0u) { if (xb_ld(&bar[XB_TMO])) break; if (sp > XB_SPIN_CAP) { atomicAdd(&bar[XB_TMO], 1u); break; } }
    }
    nloc = mine > 0u ? mine : 1u; nx = cnt > 0u ? cnt : 1u;
}
__device__ __forceinline__ void xcd_barrier(const XcdBarrier& b) {
    asm volatile("s_waitcnt vmcnt(0)" ::: "memory");
    __syncthreads();
    if (threadIdx.x == 0) {
        unsigned* bar = b.bar;
        __builtin_amdgcn_s_waitcnt(0);
        unsigned nloc = b.st[0], nx = b.st[1];
        if (nloc == 0u) { xcd_barrier_complete(bar, b.x, nloc, nx); b.st[0] = nloc; b.st[1] = nx; }
        const unsigned old = xb_add(&bar[XB_XSUB(b.x)], 1u);
        const unsigned gen = old / nloc;
        if (old + 1u == (gen + 1u) * nloc) {
            __builtin_amdgcn_fence(__ATOMIC_RELEASE, "agent");
            asm volatile("s_waitcnt vmcnt(0)" ::: "memory");
            const unsigned og = xb_add(&bar[XB_TOP], 1u);
            const unsigned tg = og / nx;
            if (og + 1u == (tg + 1u) * nx) xb_add(&bar[XB_TOPGEN], 1u);
            else XB_SPIN(xb_ld(&bar[XB_TOPGEN]) == tg, bar);
            __builtin_amdgcn_fence(__ATOMIC_ACQUIRE, "agent");
            xb_add(&bar[XB_XGEN(b.x)], 1u);
            asm volatile("s_waitcnt vmcnt(0)" ::: "memory");
        } else {
            XB_SPIN(xb_ld(&bar[XB_XGEN(b.x)]) == gen, bar);
            __builtin_amdgcn_fence(__ATOMIC_ACQUIRE, "agent");
            asm volatile("s_waitcnt vmcnt(0)" ::: "memory");
        }
    }
    __syncthreads();
}

__global__ void __launch_bounds__(NTHREADS, 2) fwd_megakernel(Params P) {
    extern __shared__ __attribute__((aligned(16))) unsigned char lds_raw[];
    cg::grid_group grid = cg::this_grid();
    Frame F;
    F.lds = (LAS unsigned char*)lds_raw;
    F.tid = threadIdx.x; F.lane = F.tid & 63; F.wave = __builtin_amdgcn_readfirstlane(F.tid >> 6);
    F.G = gridDim.x; { const int bx = blockIdx.x; F.vcu = (F.G % 8 == 0) ? (bx % 8) * (F.G / 8) + bx / 8 : bx; }
    unsigned char* ws = P.ws;
    F.vstat = (float*)(ws + WS_VSTAT); F.ss = (float*)(ws + WS_SS);
    F.Win_t = (bf16_t*)(ws + WS_WIN); F.Wab_t = (bf16_t*)(ws + WS_WAB); F.Wo_t = (bf16_t*)(ws + WS_WO); F.Wpool_t = (bf16_t*)(ws + WS_WPOOL); F.Ws_b = (bf16_t*)(ws + WS_WSB);
    F.H = (bf16_t*)(ws + WS_H); F.T = (bf16_t*)(ws + WS_T); F.PROJ = (bf16_t*)(ws + WS_PROJ);

    volatile LAS unsigned* bst = (volatile LAS unsigned*)(F.lds + 151552);
    if (F.tid < 2) bst[F.tid] = 0u;
    if (blockIdx.x == 0) { for (int e = F.tid; e < XCD_BAR_WORDS; e += NTHREADS) ((unsigned*)(ws + WS_BAR))[e] = 0u; }
    __syncthreads();
    p0_prologue(P, F);
    grid.sync();
    const XcdBarrier xbar = xcd_barrier_post((unsigned*)(ws + WS_BAR), bst);
    { pg8::Gemm g{F.H, F.Win_t, 1024, 1024, 16, 0, 0}; pg8::Order S; S.init(MTOK, DIN, F.G, (int)blockIdx.x, 1);
      EpiProj E{F.PROJ, F.vstat};
      const int c = (int)blockIdx.x, grp = ((c >> 3) & 1) + (c >= 144 ? 2 : 0);
      pg8::gemm_phase<EpiProj, pg8::Order>(F.lds, g, S, E, 0u); }
    xcd_barrier(xbar);
    { const int u0 = (int)blockIdx.x, Gp = F.G & ~7;
      if (u0 < Gp) { const int g = (u0 >> 1) & 3; if (u0 & 1) sgu_stream(P, F, u0 >> 3, Gp >> 3, g); else pool_stream(P, F, u0 >> 3, Gp >> 3, g); } }
    xcd_barrier(xbar);
    { pg8::Gemm g{F.T, F.Wab_t, 1024, 1024, 8, 1024, 1024}; pg8::Order S; S.init(MTOK, DM, F.G, (int)blockIdx.x, 2);
      EpiMerge E{F.PROJ, F.H};
      const int c = (int)blockIdx.x, grp = (c < 32) ? 0 : 1 + ((c >> 3) & 3);
      pg8::gemm_phase<EpiMerge, pg8::Order>(F.lds, g, S, E, 0u); }
    xcd_barrier(xbar);
    { pg8::Gemm g{F.H, F.Wo_t, 1024, 1024, 16, 0, 0}; pg8::Order S; S.init(MTOK, DM, F.G, (int)blockIdx.x, 1);
      EpiOut E{P.xp, P.xs, P.out, F.ss};
      const int c = (int)blockIdx.x, grp = (c < 32) ? 0 : 1 + ((c >> 3) & 3);
      pg8::gemm_phase<EpiOut, pg8::Order>(F.lds, g, S, E, 0u); }
    xcd_barrier(xbar);
    { const int gw = F.vcu * NWAVES + F.wave, NGW = F.G * NWAVES, lane = F.lane;
      f32x4 gv[4];
#pragma unroll
      for (int j = 0; j < 4; ++j) gv[j] = *((const f32x4*)P.final_g + lane + 64 * j);
      for (int m0 = gw; m0 < MTOK; m0 += 4 * NGW) {
          f32x4 v[4][4]; float r[4];
#pragma unroll
          for (int q = 0; q < 4; ++q) { const int m = m0 + q * NGW; if (m < MTOK) {
              const f32x4* xr = (const f32x4*)(P.out + (size_t)m * DM) + lane; r[q] = F.ss[m];
#pragma unroll
              for (int j = 0; j < 4; ++j) v[q][j] = xr[64 * j]; } }
#pragma unroll
          for (int q = 0; q < 4; ++q) { const int m = m0 + q * NGW; if (m < MTOK) {
              f32x4* xr = (f32x4*)(P.out + (size_t)m * DM) + lane; const float rr = 1.f / sqrtf(r[q] * (1.f / DM) + EPS);
#pragma unroll
              for (int j = 0; j < 4; ++j) xr[64 * j] = v[q][j] * rr * gv[j]; } }
      } }
}

extern "C" void kernel_launch(void* const* d_in, const int* in_sizes, int n_in, void* d_out, int out_size, void* d_ws, size_t ws_size, hipStream_t stream) {
    static int grid_blocks = 0;
    if (!grid_blocks) {
        int dev = 0, cus = 0, per_cu = 0;
        (void)hipGetDevice(&dev);
        (void)hipDeviceGetAttribute(&cus, hipDeviceAttributeMultiprocessorCount, dev);
        (void)hipFuncSetAttribute((const void*)fwd_megakernel, hipFuncAttributeMaxDynamicSharedMemorySize, LDS_BYTES);
        (void)hipOccupancyMaxActiveBlocksPerMultiprocessor(&per_cu, (const void*)fwd_megakernel, NTHREADS, LDS_BYTES);
        if (per_cu < 1) { fprintf(stderr, "occupancy query says %d blocks/CU; using 1\n", per_cu); per_cu = 1; }
        (void)hipGetLastError();
        grid_blocks = cus * per_cu;
    }
    Params p{};
    p.xp = (const float*)d_in[0]; p.xs = (const float*)d_in[1]; p.cache = (const float*)d_in[2]; p.norm_g = (const float*)d_in[3]; p.w_in = (const float*)d_in[4];
    p.w_pool = (const float*)d_in[5]; p.pool_scale = (const float*)d_in[6]; p.ln_g = (const float*)d_in[7]; p.ln_b = (const float*)d_in[8]; p.w_s = (const float*)d_in[9];
    p.b_s = (const float*)d_in[10]; p.w_a = (const float*)d_in[11]; p.w_b = (const float*)d_in[12]; p.w_o = (const float*)d_in[13]; p.final_g = (const float*)d_in[14];
    p.out = (float*)d_out; p.ws = (unsigned char*)d_ws;
    void* args[] = {&p};
    hipError_t e = hipLaunchCooperativeKernel((const void*)fwd_megakernel, dim3(grid_blocks), dim3(NTHREADS), args, LDS_BYTES, stream);
    if (e != hipSuccess) fprintf(stderr, "cooperative launch failed: %s (grid %d)\n", hipGetErrorString(e), grid_blocks);
}
```
